# Optimizing an MI355X kernel written in HIP

```python
import math
import jax, jax.numpy as jnp
from jax import lax
import numpy as np

D_MODEL = 2048
BATCH = 2
SEQ = 4096
DEPTH = 1

GRID_W = 64
CTX_LEN = 256
DIFF_HEAD_DIM = 64
DIFF_WIDTH = D_MODEL // 2
N_DIFF_HEADS = DIFF_WIDTH // (2 * DIFF_HEAD_DIM)
FOURIER_WIDTH = D_MODEL // 2
N_FOURIER_GROUPS = 4
FOURIER_GROUP_DIM = FOURIER_WIDTH // N_FOURIER_GROUPS
D_FF = 4 * D_MODEL
N_MOD = 6
Q_BLOCK = 128
ROPE_BASE = 10000.0
EPS = 1e-6
IN_COLS = 3 * DIFF_WIDTH + FOURIER_WIDTH + 2 * D_MODEL

kernel_name = "hybrid_diffattn_fourier_dit_block"


def rmsnorm(x, g):
    xf = x.astype(jnp.float32)
    y = xf * lax.rsqrt(jnp.mean(xf * xf, axis=-1, keepdims=True) + EPS)
    return (y * g.astype(jnp.float32)).astype(x.dtype)


def modulate(h, shift, scale):
    return h * (1.0 + scale) + shift


def axial_tables(seq_len):
    rows_n = seq_len // GRID_W
    row = jnp.repeat(jnp.arange(rows_n), GRID_W)
    col = jnp.tile(jnp.arange(GRID_W), rows_n)
    half = DIFF_HEAD_DIM // 2
    inv_freq = ROPE_BASE ** (-jnp.arange(0, half, 2, dtype=jnp.float32) / half)

    def cs(pos):
        ang = pos.astype(jnp.float32)[:, None] * inv_freq[None, :]
        ang = jnp.concatenate([ang, ang], axis=-1)
        return jnp.cos(ang), jnp.sin(ang)

    cr, sr = cs(row)
    cc, sc = cs(col)
    return cr, sr, cc, sc


def _rotate(x, cos, sin):
    cos = cos[None, :, None, None, :]
    sin = sin[None, :, None, None, :]
    x1, x2 = jnp.split(x, 2, axis=-1)
    return x * cos + jnp.concatenate([-x2, x1], axis=-1) * sin


def axial_rope(x, tabs):
    cr, sr, cc, sc = tabs
    half = DIFF_HEAD_DIM // 2
    xf = x.astype(jnp.float32)
    y = jnp.concatenate([_rotate(xf[..., :half], cr, sr), _rotate(xf[..., half:], cc, sc)], axis=-1)
    return y.astype(x.dtype)


def diff_attention(q, k, v, lam):
    B, Lq, H, _, Dh = q.shape
    nblk = Lq // Q_BLOCK
    scale = Dh ** -0.5
    kf = k.astype(jnp.float32)
    vf = v.astype(jnp.float32)
    qb = q.astype(jnp.float32).reshape(B, nblk, Q_BLOCK, H, 2, Dh).transpose(1, 0, 2, 3, 4, 5)

    def block(qblk):
        s = jnp.einsum('bqhcd,bkhcd->bhcqk', qblk, kf) * scale
        p = jax.nn.softmax(s, axis=-1)
        a = p[:, :, 0] - lam * p[:, :, 1]
        return jnp.einsum('bhqk,bkhe->bqhe', a, vf)

    o = lax.map(block, qb)
    return o.transpose(1, 0, 2, 3, 4).reshape(B, Lq, H, 2 * Dh)


def fourier_mix(f):
    B, L, _ = f.shape
    u = f.reshape(B, L, N_FOURIER_GROUPS, FOURIER_GROUP_DIM).astype(jnp.float32)
    y = jnp.fft.fft2(u, axes=(1, 3), norm="ortho").real
    return y.reshape(B, L, FOURIER_WIDTH).astype(f.dtype)


def split_proj(p):
    B, L, _ = p.shape
    o = 0
    q = p[..., o:o + DIFF_WIDTH].reshape(B, L, N_DIFF_HEADS, 2, DIFF_HEAD_DIM); o += DIFF_WIDTH
    k = p[..., o:o + DIFF_WIDTH].reshape(B, L, N_DIFF_HEADS, 2, DIFF_HEAD_DIM); o += DIFF_WIDTH
    v = p[..., o:o + DIFF_WIDTH].reshape(B, L, N_DIFF_HEADS, 2 * DIFF_HEAD_DIM); o += DIFF_WIDTH
    f = p[..., o:o + FOURIER_WIDTH]; o += FOURIER_WIDTH
    ga = p[..., o:o + D_MODEL]; o += D_MODEL
    gf = p[..., o:o + D_MODEL]
    return q, k, v, f, ga, gf


def merge_branches(attn_o, f, ga, gf, g_subln, lam_init, w_attn_br, w_four_br, w_out):
    B, L = attn_o.shape[:2]
    a = (rmsnorm(attn_o, g_subln) * (1.0 - lam_init)).reshape(B, L, DIFF_WIDTH)
    ya = a @ w_attn_br
    yf = fourier_mix(f) @ w_four_br
    merged = jax.nn.sigmoid(ga) * ya + jax.nn.sigmoid(gf) * yf
    return merged @ w_out


def sq_relu_mlp(h, w1, w2):
    z = jax.nn.relu(h @ w1)
    return (z * z) @ w2


def setup_inputs(seed: int = 0) -> dict:
    key = jax.random.key(seed)
    ks = jax.random.split(key, 24)
    nrm = lambda k, shape, s: jax.random.normal(k, shape, jnp.float32) * s
    gain = lambda k, shape: 1.0 + 0.02 * jax.random.normal(k, shape, jnp.float32)
    return {
        "x": nrm(ks[0], (BATCH, SEQ, D_MODEL), 1.0),
        "c": nrm(ks[1], (BATCH, D_MODEL), 1.0),
        "ctx": nrm(ks[2], (BATCH, CTX_LEN, D_MODEL), 1.0),
        "c_ctx": nrm(ks[3], (D_MODEL,), 1.0),
        "w_ada": nrm(ks[4], (DEPTH, D_MODEL, N_MOD * D_MODEL), 0.5 * D_MODEL ** -0.5),
        "b_ada": nrm(ks[5], (DEPTH, N_MOD * D_MODEL), 0.02),
        "g_norm1": gain(ks[6], (DEPTH, D_MODEL)),
        "w_in": nrm(ks[7], (DEPTH, D_MODEL, IN_COLS), D_MODEL ** -0.5),
        "lam_q1": nrm(ks[8], (DEPTH, DIFF_HEAD_DIM), 0.1),
        "lam_k1": nrm(ks[9], (DEPTH, DIFF_HEAD_DIM), 0.1),
        "lam_q2": nrm(ks[10], (DEPTH, DIFF_HEAD_DIM), 0.1),
        "lam_k2": nrm(ks[11], (DEPTH, DIFF_HEAD_DIM), 0.1),
        "g_subln": gain(ks[12], (DEPTH, 2 * DIFF_HEAD_DIM)),
        "w_attn_br": nrm(ks[13], (DEPTH, DIFF_WIDTH, D_MODEL), DIFF_WIDTH ** -0.5),
        "w_four_br": nrm(ks[14], (DEPTH, FOURIER_WIDTH, D_MODEL), FOURIER_WIDTH ** -0.5),
        "w_out": nrm(ks[15], (DEPTH, D_MODEL, D_MODEL), D_MODEL ** -0.5),
        "g_norm2": gain(ks[16], (DEPTH, D_MODEL)),
        "w_mlp_in": nrm(ks[17], (DEPTH, D_MODEL, D_FF), D_MODEL ** -0.5),
        "w_mlp_out": nrm(ks[18], (DEPTH, D_FF, D_MODEL), D_FF ** -0.5),
        "g_final": gain(ks[19], (D_MODEL,)),
    }


def reference(x, c, ctx, c_ctx, w_ada, b_ada, g_norm1, w_in, lam_q1, lam_k1, lam_q2, lam_k2,
              g_subln, w_attn_br, w_four_br, w_out, g_norm2, w_mlp_in, w_mlp_out, g_final):
    tabs = axial_tables(x.shape[1])
    xl = x
    xc = ctx
    for l in range(DEPTH):
        lam_init = 0.8 - 0.6 * math.exp(-0.3 * l)
        last = l == DEPTH - 1
        mod = (jax.nn.silu(c) @ w_ada[l] + b_ada[l])[:, None, :]
        sh1, sc1, gt1, sh2, sc2, gt2 = jnp.split(mod, N_MOD, axis=-1)
        modc = jax.nn.silu(c_ctx) @ w_ada[l] + b_ada[l]
        sh1c, sc1c, gt1c, sh2c, sc2c, gt2c = jnp.split(modc, N_MOD, axis=-1)
        lam = (jnp.exp(jnp.sum(lam_q1[l].astype(jnp.float32) * lam_k1[l].astype(jnp.float32)))
               - jnp.exp(jnp.sum(lam_q2[l].astype(jnp.float32) * lam_k2[l].astype(jnp.float32)))
               + lam_init)

        hl = modulate(rmsnorm(xl, g_norm1[l]), sh1, sc1)
        hc = modulate(rmsnorm(xc, g_norm1[l]), sh1c, sc1c)
        ql, kl, vl, fl, gal, gfl = split_proj(hl @ w_in[l])
        qc, kc, vc, fc, gac, gfc = split_proj(hc @ w_in[l])
        k_all = jnp.concatenate([axial_rope(kl, tabs), kc.astype(kl.dtype)], axis=1)
        v_all = jnp.concatenate([vl, vc.astype(vl.dtype)], axis=1)
        ol = diff_attention(axial_rope(ql, tabs), k_all, v_all, lam)
        xl_mid = xl + gt1 * merge_branches(ol, fl, gal, gfl, g_subln[l], lam_init,
                                           w_attn_br[l], w_four_br[l], w_out[l])
        if not last:
            oc = diff_attention(qc, kc, vc, lam)
            xc = xc + gt1c * merge_branches(oc, fc, gac, gfc, g_subln[l], lam_init,
                                            w_attn_br[l], w_four_br[l], w_out[l])
            xc = xc + gt2c * sq_relu_mlp(modulate(rmsnorm(xc, g_norm2[l]), sh2c, sc2c),
                                         w_mlp_in[l], w_mlp_out[l])
        xl = xl_mid + gt2 * sq_relu_mlp(modulate(rmsnorm(xl_mid, g_norm2[l]), sh2, sc2),
                                        w_mlp_in[l], w_mlp_out[l])
    return rmsnorm(xl, g_final)
```

```cpp
#include <hip/hip_cooperative_groups.h>
namespace cg = cooperative_groups;
#include <cstddef>
constexpr int NWAVES = 8;
constexpr int DM_ = 2048, SEQ_ = 4096, BATCH_ = 2, CTXL = 256, MTOK = BATCH_ * SEQ_  , MCTX = BATCH_ * CTXL  , INCOLS = 8192, DFF = 8192, NMOD = 6 * DM_  ;
constexpr float EPS_ = 1e-6f, LAM_INIT = 0.2f;
constexpr size_t MiB = 1u << 20;
constexpr size_t WS_CTL = 0, CTL_ZERO_BYTES = 1 * MiB;
constexpr size_t WS_MOD = 256 * 1024;
constexpr size_t WS_ROPEC = 1 * MiB, WS_ROPES = 1 * MiB + 4096, WS_CS = 1 * MiB + 65536;
constexpr size_t WS_WATT = 2 * MiB, WS_WFOUR = 6 * MiB, WS_WOUT = 10 * MiB;
constexpr size_t WS_WIN = 18 * MiB;
constexpr size_t WS_XN = 50 * MiB;
constexpr size_t WS_DFTM = 84 * MiB;
constexpr size_t WS_Q = 148 * MiB, WS_K = 164 * MiB, WS_V = 181 * MiB, WS_F = 198 * MiB, WS_SGA = 214 * MiB, WS_SGF = 246 * MiB;
constexpr size_t WS_AATT = WS_Q, WS_YB = WS_K, WS_Z = WS_Q;
constexpr size_t WS_TT = 278 * MiB;
constexpr size_t WS_O0 = 310 * MiB, WS_O1 = 326 * MiB, WS_END = 342 * MiB;
constexpr int CW_BAR = 4096;
constexpr int RING_OFF = 0, RING_BYTES = 131072;
constexpr int LDSCTL_OFF = RING_BYTES, MISC_OFF = LDSCTL_OFF + 320;
constexpr int LDS_BYTES = 147456;
static_assert(MISC_OFF + 128 <= LDS_BYTES, "LDS map");
#include <hip/hip_runtime.h>
#include <cstdio>
#include <cstdint>
namespace pg8 {
#define PG8_LAS __attribute__((address_space(3)))
typedef unsigned short bf16_t;
typedef short bf16x8 __attribute__((ext_vector_type(8)));
typedef float f32x4 __attribute__((ext_vector_type(4)));
typedef unsigned u32x4 __attribute__((ext_vector_type(4)));
constexpr int BM = 256, BK = 64, HALF = 128, HTB = HALF * BK * 2  , STAGE_BYTES = 8 * HTB, NXCD = 8, WGM = 8;

__host__ __device__ __forceinline__ int lds_byte(int r, int c) { const int st = (r >> 4) * 2 + (c >> 5), rr = r & 15, cc = c & 31, ob = rr * 64 + cc * 2; return st * 1024 + (ob ^ (((ob >> 9) & 1) << 5)); }
__host__ __device__ __forceinline__ void stage_rc(int b, int& R, int& C) { const int st = b / 1024, sb = b % 1024, swz = sb ^ (((sb >> 9) & 1) << 5); R = (st >> 1) * 16 + swz / 64; C = (st & 1) * 32 + (swz % 64) / 2; }
__host__ __device__ __forceinline__ int perm32(int rho) { const int n = rho >> 4, i = rho & 15; return 8 * (i >> 2) + 4 * n + (i & 3); }

struct Unit { int pm, pn, z; size_t aoff, boff; };
struct Gemm { const unsigned char* base; int lda, ldb, K; };
__device__ __forceinline__ unsigned cvt_pk_bf16(float lo, float hi) { unsigned r; asm volatile("v_cvt_pk_bf16_f32 %0, %1, %2" : "=v"(r) : "v"(lo), "v"(hi)); return r; }
__device__ __forceinline__ u32x4 pack8(const f32x4 v0, const f32x4 v1) { u32x4 w; w.x = cvt_pk_bf16(v0[0], v0[1]); w.y = cvt_pk_bf16(v0[2], v0[3]); w.z = cvt_pk_bf16(v1[0], v1[1]); w.w = cvt_pk_bf16(v1[2], v1[3]); return w; }
__device__ __forceinline__ void unpack8(const u32x4 w, f32x4& v0, f32x4& v1) {
    v0[0] = __uint_as_float(w.x << 16); v0[1] = __uint_as_float(w.x & 0xffff0000u); v0[2] = __uint_as_float(w.y << 16); v0[3] = __uint_as_float(w.y & 0xffff0000u);
    v1[0] = __uint_as_float(w.z << 16); v1[1] = __uint_as_float(w.z & 0xffff0000u); v1[2] = __uint_as_float(w.w << 16); v1[3] = __uint_as_float(w.w & 0xffff0000u); }

struct Map2D {
    int nM, nN, nwg;
    __device__ __forceinline__ void init(int nM_, int nN_) { nM = nM_; nN = nN_; nwg = nM_ * nN_; }
    __device__ __forceinline__ void map(int L, int& pm, int& pn) const {
        int wgid = L; { const int q = nwg / NXCD, r = nwg % NXCD, xcd = wgid % NXCD, off = wgid / NXCD; wgid = (xcd < r ? xcd * (q + 1) : r * (q + 1) + (xcd - r) * q) + off; }
        const int nig = WGM * nN, gid = wgid / nig, fm = gid * WGM, gsz = (nM - fm) < WGM ? (nM - fm) : WGM;
        pm = fm + ((wgid % nig) % gsz); pn = (wgid % nig) / gsz;
    }
};
struct SchedTiles {
    Map2D mp; int G, c; size_t offA, offB, tA, tB;
    __device__ __forceinline__ bool next(int i, Unit& u) const { const int L = i * G + c; if (L >= mp.nwg) return false; mp.map(L, u.pm, u.pn); u.z = 0; u.aoff = offA + (size_t)u.pm * tA; u.boff = offB + (size_t)u.pn * tB; return true; }
};
struct SchedG1 {
    Map2D mp; int G, c; size_t offA, offB;
    __device__ __forceinline__ bool next(int i, Unit& u) const { const int L = i * G + c;
        if (L < 1024) mp.map(L, u.pm, u.pn); else { const int e = L - 1024; if (e >= 16) return false; u.pm = 32 + (e >> 3); u.pn = 4 + (e & 7); }
        u.z = 0; u.aoff = offA + (size_t)u.pm * (256 * 2048 * 2); u.boff = offB + (size_t)u.pn * (256 * 2048 * 2); return true; }
};
struct SchedF1 {
    int G, c; size_t offCS, offF;
    __device__ __forceinline__ bool next(int i, Unit& u) const { const int L = i * G + c; if (L >= 256) return false;
        u.z = L >> 6; const int r = L & 63; u.pm = r & 1; u.pn = r >> 1; u.aoff = offCS + (size_t)u.pm * (256 * 256 * 2); u.boff = offF + ((size_t)u.pn * 256 * 1024 + (size_t)u.z * 256) * 2; return true; }
};
struct SchedF2 {
    int G, c; size_t offD, offT;
    __device__ __forceinline__ bool next(int i, Unit& u) const { const int L = i * G + c; if (L >= 256) return false;
        const int x = L & 7, idx = L >> 3, cs = idx & 1, bg = idx >> 2; u.pm = 2 * x + ((idx >> 1) & 1); u.pn = 0; u.z = (bg << 1) | cs;
        u.aoff = offD + ((size_t)u.pm * 256 * 8192 + (size_t)cs * 4096) * 2; u.boff = offT + ((size_t)bg * 256 * 8192 + (size_t)cs * 4096) * 2; return true; }
};
struct SchedMerged {
    Map2D mp; int G, c; size_t offA0, offB0, offA1, offB1;
    __device__ __forceinline__ bool next(int i, Unit& u) const { const int L = (i >> 1) * G + c; if (L >= mp.nwg) return false; mp.map(L, u.pm, u.pn); u.z = i & 1;
        u.aoff = (u.z ? offA1 : offA0) + (size_t)u.pm * (256 * 1024 * 2); u.boff = (u.z ? offB1 : offB0) + (size_t)u.pn * (256 * 1024 * 2); return true; }
};

constexpr float QSCALE = 0.125f * 1.4426950408889634f;
struct EpiG1 {
    static constexpr bool PERM = true;
    unsigned char* ws; const float *ropec, *ropes;
    __device__ __forceinline__ bool operator()(f32x4 (&acc)[2][2][4][2], const Unit& u_, int wr, int wc, int fr, int fq) const {
        Unit u; u.pm = u_.pm; u.pn = u_.pn; u.z = u_.z; asm volatile("" : "+s"(u.pm), "+s"(u.pn), "+s"(u.z));
        const int type = u.pn >> 2;
        const bool ctx = u.pm >= 32;
        if (type <= 1 && !ctx) {
            bf16_t* O = (bf16_t*)(ws + WS_Q + (size_t)type * (WS_K - WS_Q)); const float sc = type == 0 ? QSCALE : 1.f;
            const int cl = (u.pn & 3) * 256 + wc * 32 + 8 * fq;
#pragma unroll
            for (int ai = 0; ai < 2; ++ai)
#pragma unroll
                for (int m = 0; m < 4; ++m) {
                    const int tok = u.pm * BM + ai * HALF + wr * 64 + m * 16 + fr, b = tok >> 12, l = tok & 4095;
                    const int pos = (wc & 1) ? (l & 63) : (l >> 6);
                    const float* cp = ropec + pos * 16 + 8 * (fq & 1); const float* sp = ropes + pos * 16 + 8 * (fq & 1);
                    const f32x4 c0 = *(const f32x4*)cp, c1 = *(const f32x4*)(cp + 4); f32x4 s0 = *(const f32x4*)sp, s1 = *(const f32x4*)(sp + 4);
                    if (fq < 2) { s0 = -s0; s1 = -s1; }
                    const size_t orow = type == 0 ? (size_t)tok : (size_t)(b * 4352 + l);
                    bf16_t* rowp = O + orow * 1024 + cl;
#pragma unroll
                    for (int bj = 0; bj < 2; ++bj) { const f32x4 v0 = acc[ai][bj][m][0], v1 = acc[ai][bj][m][1]; f32x4 p0, p1;
#pragma unroll
                        for (int j = 0; j < 4; ++j) { p0[j] = __shfl_xor(v0[j], 32); p1[j] = __shfl_xor(v1[j], 32); }
                        const f32x4 o0 = (v0 * c0 + p0 * s0) * sc, o1 = (v1 * c1 + p1 * s1) * sc;
                        *(u32x4*)(rowp + bj * HALF) = pack8(o0, o1); }
                }
        } else if (type <= 3) {
            bf16_t* O = (bf16_t*)(ws + WS_K + (size_t)(type - 1) * (WS_V - WS_K));
            const int cl = (u.pn & 3) * 256 + wc * 32 + 8 * fq;
#pragma unroll
            for (int ai = 0; ai < 2; ++ai)
#pragma unroll
                for (int m = 0; m < 4; ++m) {
                    const int r = u.pm * BM + ai * HALF + wr * 64 + m * 16 + fr; size_t orow;
                    if (ctx) { const int j = r - 8192; orow = (size_t)((j >> 8) * 4352 + 4096 + (j & 255)); }
                    else if (type == 3) orow = (size_t)r;
                    else orow = (size_t)((r >> 12) * 4352 + (r & 4095));
                    bf16_t* rowp = O + orow * 1024 + cl;
#pragma unroll
                    for (int bj = 0; bj < 2; ++bj) *(u32x4*)(rowp + bj * HALF) = pack8(acc[ai][bj][m][0], acc[ai][bj][m][1]);
                }
        } else {
            bf16_t* O = (bf16_t*)(ws + WS_SGA + (size_t)((type - 4) >> 1) * (WS_SGF - WS_SGA));
            const int cl = (u.pn & 7) * 256 + wc * 32 + 8 * fq;
#pragma unroll
            for (int ai = 0; ai < 2; ++ai)
#pragma unroll
                for (int m = 0; m < 4; ++m) {
                    const int r = u.pm * BM + ai * HALF + wr * 64 + m * 16 + fr; bf16_t* rowp = O + (size_t)r * 2048 + cl;
#pragma unroll
                    for (int bj = 0; bj < 2; ++bj) { f32x4 v0 = acc[ai][bj][m][0], v1 = acc[ai][bj][m][1];
#pragma unroll
                        for (int j = 0; j < 4; ++j) { v0[j] = __builtin_amdgcn_rcpf(1.f + __expf(-v0[j])); v1[j] = __builtin_amdgcn_rcpf(1.f + __expf(-v1[j])); }
                        *(u32x4*)(rowp + bj * HALF) = pack8(v0, v1); }
                }
        }
        return false;
    }
};
struct EpiF1 {
    static constexpr bool PERM = true;
    bf16_t* TT;
    __device__ __forceinline__ bool operator()(f32x4 (&acc)[2][2][4][2], const Unit& u_, int wr, int wc, int fr, int fq) const {
        Unit u; u.pm = u_.pm; u.pn = u_.pn; u.z = u_.z; asm volatile("" : "+s"(u.pm), "+s"(u.pn), "+s"(u.z));
#pragma unroll
        for (int ai = 0; ai < 2; ++ai)
#pragma unroll
            for (int m = 0; m < 4; ++m) { const int n = ai * HALF + wr * 64 + m * 16 + fr;
#pragma unroll
                for (int bj = 0; bj < 2; ++bj) { const int t0 = u.pn * BM + bj * HALF + wc * 32 + 8 * fq, b = t0 >> 12, l = t0 & 4095;
                    *(u32x4*)(TT + ((size_t)((b * 4 + u.z) * 256 + n)) * 8192 + u.pm * 4096 + l) = pack8(acc[ai][bj][m][0], acc[ai][bj][m][1]); } }
        return false;
    }
};
struct EpiF2 {
    static constexpr bool PERM = false;
    float* Yc; size_t ys_off;
    __device__ __forceinline__ bool operator()(f32x4 (&acc)[2][2][4][2], const Unit& u_, int wr, int wc, int fr, int fq) const {
        Unit u; u.pm = u_.pm; u.pn = u_.pn; u.z = u_.z; asm volatile("" : "+s"(u.pm), "+s"(u.pn), "+s"(u.z));
        const int cs = u.z & 1, bg = u.z >> 1, b = bg >> 2, g = bg & 3; float* Y = Yc + (size_t)cs * ys_off;
#pragma unroll
        for (int ai = 0; ai < 2; ++ai)
#pragma unroll
            for (int m = 0; m < 4; ++m) { const int lp = u.pm * BM + ai * HALF + wr * 64 + m * 16 + fr; float* rowp = Y + ((size_t)(b * 4096 + lp)) * 1024 + g * 256 + wc * 32 + 4 * fq;
#pragma unroll
                for (int bj = 0; bj < 2; ++bj)
#pragma unroll
                    for (int n = 0; n < 2; ++n) *(f32x4*)(rowp + bj * HALF + n * 16) = acc[ai][bj][m][n]; }
        return false;
    }
};
struct EpiMerged {
    static constexpr bool PERM = true;
    const bf16_t *SGA, *SGF; bf16_t* Mb;
    __device__ __forceinline__ bool operator()(f32x4 (&acc)[2][2][4][2], const Unit& u_, int wr, int wc, int fr, int fq) const {
        Unit u; u.pm = u_.pm; u.pn = u_.pn; u.z = u_.z; asm volatile("" : "+s"(u.pm), "+s"(u.pn), "+s"(u.z));
        const int cl = u.pn * BM + wc * 32 + 8 * fq;
#pragma unroll
        for (int ai = 0; ai < 2; ++ai)
#pragma unroll
            for (int m = 0; m < 4; ++m) { const size_t off = (size_t)(u.pm * BM + ai * HALF + wr * 64 + m * 16 + fr) * 2048 + cl;
#pragma unroll
                for (int bj = 0; bj < 2; ++bj) { f32x4 f0, f1; unpack8(*(const u32x4*)(SGF + off + bj * HALF), f0, f1);
                    if (u.z == 0) { f32x4 a0, a1; unpack8(*(const u32x4*)(SGA + off + bj * HALF), a0, a1);
#pragma unroll
                        for (int j = 0; j < 4; ++j) { acc[ai][bj][m][0][j] *= a0[j] * __builtin_amdgcn_rcpf(f0[j]); acc[ai][bj][m][1][j] *= a1[j] * __builtin_amdgcn_rcpf(f1[j]); }
                    } else *(u32x4*)(Mb + off + bj * HALF) = pack8(acc[ai][bj][m][0] * f0, acc[ai][bj][m][1] * f1); } }
        return u.z == 0;
    }
};
struct EpiRes {
    static constexpr bool PERM = false;
    const float* base; float* out; const float* gate;
    __device__ __forceinline__ bool operator()(f32x4 (&acc)[2][2][4][2], const Unit& u_, int wr, int wc, int fr, int fq) const {
        Unit u; u.pm = u_.pm; u.pn = u_.pn; u.z = u_.z; asm volatile("" : "+s"(u.pm), "+s"(u.pn), "+s"(u.z));
        const int b = u.pm >> 4, col0 = u.pn * BM + wc * 32 + 4 * fq; f32x4 gv[2][2];
#pragma unroll
        for (int bj = 0; bj < 2; ++bj)
#pragma unroll
            for (int n = 0; n < 2; ++n) gv[bj][n] = *(const f32x4*)(gate + (size_t)b * 12288 + col0 + bj * HALF + n * 16);
#pragma unroll
        for (int ai = 0; ai < 2; ++ai)
#pragma unroll
            for (int m = 0; m < 4; ++m) { const size_t off = (size_t)(u.pm * BM + ai * HALF + wr * 64 + m * 16 + fr) * 2048 + col0;
#pragma unroll
                for (int bj = 0; bj < 2; ++bj)
#pragma unroll
                    for (int n = 0; n < 2; ++n) *(f32x4*)(out + off + bj * HALF + n * 16) = *(const f32x4*)(base + off + bj * HALF + n * 16) + gv[bj][n] * acc[ai][bj][m][n]; }
        return false;
    }
};
struct EpiRelu2 {
    static constexpr bool PERM = true;
    bf16_t* Z;
    __device__ __forceinline__ bool operator()(f32x4 (&acc)[2][2][4][2], const Unit& u_, int wr, int wc, int fr, int fq) const {
        Unit u; u.pm = u_.pm; u.pn = u_.pn; u.z = u_.z; asm volatile("" : "+s"(u.pm), "+s"(u.pn), "+s"(u.z));
        const int cl = u.pn * BM + wc * 32 + 8 * fq;
#pragma unroll
        for (int ai = 0; ai < 2; ++ai)
#pragma unroll
            for (int m = 0; m < 4; ++m) { bf16_t* rowp = Z + (size_t)(u.pm * BM + ai * HALF + wr * 64 + m * 16 + fr) * 8192 + cl;
#pragma unroll
                for (int bj = 0; bj < 2; ++bj) { f32x4 v0 = acc[ai][bj][m][0], v1 = acc[ai][bj][m][1];
#pragma unroll
                    for (int j = 0; j < 4; ++j) { const float a = fmaxf(v0[j], 0.f), c = fmaxf(v1[j], 0.f); v0[j] = a * a; v1[j] = c * c; }
                    *(u32x4*)(rowp + bj * HALF) = pack8(v0, v1); } }
        return false;
    }
};
template <class Epi, class Sched, bool ALIGN_EPI = false, bool SP2 = false>
__device__ __forceinline__ void gemm_phase(PG8_LAS unsigned char* lds, const Gemm g, const Sched& S, const Epi& E) {
    const int tid = threadIdx.x, wid = __builtin_amdgcn_readfirstlane(tid >> 6), lane = tid & 63, wr = wid >> 2, wc = wid & 3, fr = lane & 15, fq = lane >> 4;
    int nt = g.K / BK; asm volatile("" : "+s"(nt));
    unsigned voffA[2], voffB[2];
#pragma unroll
    for (int i = 0; i < 2; ++i) { int R, C; stage_rc(tid * 16 + i * 8192, R, C); const int Rb = Epi::PERM ? ((R & ~31) + perm32(R & 31)) : R;
        voffA[i] = (unsigned)(R * g.lda + C) * 2u; voffB[i] = (unsigned)(Rb * g.ldb + C) * 2u; }
    const size_t kstep = (size_t)(BK * 2);
    const size_t hstepA = (size_t)HALF * g.lda * 2, hstepB = (size_t)HALF * g.ldb * 2;
    const unsigned ldsw = (unsigned)wid * 1024u;
    const int aoff = lds_byte(wr * 64 + fr, fq * 8), boff = lds_byte(wc * 32 + fr, fq * 8);
#define PG8_SA(b, h) (((b) * 2 + (h)) * HTB)
#define PG8_SB(b, h) ((4 + (b) * 2 + (h)) * HTB)
#define PG8_STAGE(bufoff, gbase, voff) do { _Pragma("unroll") for (int _i = 0; _i < 2; ++_i) \
        __builtin_amdgcn_global_load_lds((const unsigned*)((const char*)(gbase) + (voff)[_i]), (PG8_LAS unsigned*)(lds + (bufoff) + ldsw + _i * 8192), 16, 0, 0); } while (0)
#define PG8_LDA(dst, b, h) do { _Pragma("unroll") for (int m = 0; m < 4; ++m) _Pragma("unroll") for (int k = 0; k < 2; ++k) dst[m][k] = *(const PG8_LAS bf16x8*)(lds + PG8_SA(b, h) + aoff + m * 2048 + k * 1024); } while (0)
#define PG8_LDB(dst, b, h) do { _Pragma("unroll") for (int n = 0; n < 2; ++n) _Pragma("unroll") for (int k = 0; k < 2; ++k) dst[n][k] = *(const PG8_LAS bf16x8*)(lds + PG8_SB(b, h) + boff + n * 2048 + k * 1024); } while (0)
#define PG8_MMA(ai, bj, At, Bt) do { __builtin_amdgcn_s_setprio(1); _Pragma("unroll") for (int m = 0; m < 4; ++m) _Pragma("unroll") for (int n = 0; n < 2; ++n) _Pragma("unroll") for (int k = 0; k < 2; ++k) \
        acc[ai][bj][m][n] = __builtin_amdgcn_mfma_f32_16x16x32_bf16(Bt[n][k], At[m][k], acc[ai][bj][m][n], 0, 0, 0); __builtin_amdgcn_s_setprio(0); } while (0)
#define PG8_WAIT_V(n) asm volatile("s_waitcnt vmcnt(" #n ")" ::: "memory")
#define PG8_WAIT_L(n) asm volatile("s_waitcnt lgkmcnt(" #n ")" ::: "memory")
#define PG8_BAR __builtin_amdgcn_s_barrier()
#define PG8_SCHED __builtin_amdgcn_sched_barrier(0)
    Unit cur, nxt; int ui = 0;
    if (!S.next(0, cur)) return;
    f32x4 acc[2][2][4][2];
#pragma unroll
    for (int a = 0; a < 2; ++a)
#pragma unroll
        for (int b = 0; b < 2; ++b)
#pragma unroll
            for (int m = 0; m < 4; ++m)
#pragma unroll
                for (int n = 0; n < 2; ++n) acc[a][b][m][n] = (f32x4){0.f, 0.f, 0.f, 0.f};
    bf16x8 At[4][2], B0[2][2], B1[2][2];
    const char* cA = (const char*)g.base + cur.aoff; const char* cB = (const char*)g.base + cur.boff;

    if constexpr (SP2) {
        PG8_STAGE(PG8_SB(0, 0), cB, voffB); PG8_STAGE(PG8_SB(0, 1), cB + hstepB, voffB); PG8_STAGE(PG8_SA(0, 0), cA, voffA); PG8_STAGE(PG8_SA(0, 1), cA + hstepA, voffA);
        if (wr == 1) PG8_BAR;
        PG8_WAIT_V(2); PG8_BAR;
        PG8_STAGE(PG8_SB(1, 0), cB + kstep, voffB); PG8_STAGE(PG8_SA(1, 0), cA + kstep, voffA); PG8_STAGE(PG8_SB(1, 1), cB + hstepB + kstep, voffB);
        PG8_WAIT_V(6); PG8_BAR;
    } else {
        PG8_STAGE(PG8_SB(0, 0), cB, voffB); PG8_STAGE(PG8_SA(0, 0), cA, voffA); PG8_STAGE(PG8_SB(0, 1), cB + hstepB, voffB); PG8_STAGE(PG8_SA(0, 1), cA + hstepA, voffA);
        if (wr == 1) PG8_BAR;
        PG8_WAIT_V(4); PG8_BAR;
        PG8_STAGE(PG8_SB(1, 0), cB + kstep, voffB); PG8_STAGE(PG8_SA(1, 0), cA + kstep, voffA); PG8_STAGE(PG8_SB(1, 1), cB + hstepB + kstep, voffB);
        PG8_WAIT_V(6); PG8_BAR;
    }
    for (;;) {
        const bool has_next = S.next(ui + 1, nxt);
        const char* nA = has_next ? (const char*)g.base + nxt.aoff : cA; const char* nB = has_next ? (const char*)g.base + nxt.boff : cB;
        for (int t = 0; t < nt; t += 2) {
            const bool last = (t == nt - 2);
            const char* a1 = cA + (size_t)(t + 1) * kstep;
            const char* a2 = last ? nA : cA + (size_t)(t + 2) * kstep; const char* b2 = last ? nB : cB + (size_t)(t + 2) * kstep;
            const char* a3 = a2 + kstep; const char* b3 = b2 + kstep;

            if constexpr (SP2) {
            PG8_LDB(B0, 0, 0); PG8_LDB(B1, 0, 1); PG8_SCHED; PG8_LDA(At, 0, 0); PG8_STAGE(PG8_SA(1, 1), a1 + hstepA, voffA);
            PG8_WAIT_V(8); PG8_WAIT_L(0); PG8_BAR; PG8_MMA(0, 0, At, B0); PG8_MMA(0, 1, At, B1); PG8_BAR; PG8_SCHED;
            PG8_LDA(At, 0, 1); PG8_STAGE(PG8_SB(0, 0), b2, voffB); PG8_STAGE(PG8_SB(0, 1), b2 + hstepB, voffB); PG8_STAGE(PG8_SA(0, 0), a2, voffA);
            PG8_WAIT_V(8); PG8_WAIT_L(0); PG8_BAR; PG8_MMA(1, 0, At, B0); PG8_MMA(1, 1, At, B1); PG8_BAR; PG8_SCHED;
            PG8_LDB(B0, 1, 0); PG8_LDB(B1, 1, 1); PG8_SCHED; PG8_LDA(At, 1, 0); PG8_STAGE(PG8_SA(0, 1), a2 + hstepA, voffA);
            PG8_WAIT_V(8); PG8_WAIT_L(0); PG8_BAR; PG8_MMA(0, 0, At, B0); PG8_MMA(0, 1, At, B1); PG8_BAR; PG8_SCHED;
            PG8_LDA(At, 1, 1); PG8_STAGE(PG8_SB(1, 0), b3, voffB); PG8_STAGE(PG8_SB(1, 1), b3 + hstepB, voffB); PG8_STAGE(PG8_SA(1, 0), a3, voffA);
            PG8_WAIT_V(8); PG8_WAIT_L(0); PG8_BAR; PG8_MMA(1, 0, At, B0); PG8_MMA(1, 1, At, B1); PG8_BAR; PG8_SCHED;
            } else {
            PG8_LDB(B0, 0, 0); PG8_SCHED; PG8_LDA(At, 0, 0); PG8_STAGE(PG8_SA(1, 1), a1 + hstepA, voffA);
            PG8_WAIT_L(8); PG8_BAR; PG8_WAIT_L(0); PG8_MMA(0, 0, At, B0); PG8_BAR; PG8_SCHED;
            PG8_LDB(B1, 0, 1); PG8_STAGE(PG8_SB(0, 0), b2, voffB);
            PG8_BAR; PG8_WAIT_L(0); PG8_MMA(0, 1, At, B1); PG8_BAR;
            PG8_LDA(At, 0, 1); PG8_STAGE(PG8_SA(0, 0), a2, voffA);
            PG8_BAR; PG8_WAIT_L(0); PG8_MMA(1, 0, At, B0); PG8_BAR; PG8_SCHED;
            PG8_STAGE(PG8_SB(0, 1), b2 + hstepB, voffB);
            PG8_WAIT_V(6); PG8_BAR; PG8_MMA(1, 1, At, B1); PG8_BAR;
            PG8_LDB(B0, 1, 0); PG8_SCHED; PG8_LDA(At, 1, 0); PG8_STAGE(PG8_SA(0, 1), a2 + hstepA, voffA);
            PG8_WAIT_L(8); PG8_BAR; PG8_WAIT_L(0); PG8_MMA(0, 0, At, B0); PG8_BAR; PG8_SCHED;
            PG8_LDB(B1, 1, 1); PG8_STAGE(PG8_SB(1, 0), b3, voffB);
            PG8_BAR; PG8_WAIT_L(0); PG8_MMA(0, 1, At, B1); PG8_BAR;
            PG8_LDA(At, 1, 1); PG8_STAGE(PG8_SA(1, 0), a3, voffA);
            PG8_BAR; PG8_WAIT_L(0); PG8_MMA(1, 0, At, B0); PG8_BAR; PG8_SCHED;
            PG8_STAGE(PG8_SB(1, 1), b3 + hstepB, voffB);
            PG8_WAIT_V(6); PG8_BAR; PG8_MMA(1, 1, At, B1); PG8_BAR;
            }
        }
        if constexpr (ALIGN_EPI) { if (wr == 0) PG8_BAR; }
        const bool keep = E(acc, cur, wr, wc, fr, fq);
        if (!has_next) break;
        if (!keep)
#pragma unroll
        for (int a = 0; a < 2; ++a)
#pragma unroll
            for (int b = 0; b < 2; ++b)
#pragma unroll
                for (int m = 0; m < 4; ++m)
#pragma unroll
                    for (int n = 0; n < 2; ++n) acc[a][b][m][n] = (f32x4){0.f, 0.f, 0.f, 0.f};
        cur = nxt; cA = nA; cB = nB; ++ui;
        if constexpr (ALIGN_EPI) { if (wr == 1) PG8_BAR; }
    }
    PG8_WAIT_V(0);
    if constexpr (!ALIGN_EPI) { if (wr == 0) PG8_BAR; }
    PG8_BAR;
#undef PG8_SA
#undef PG8_SB
#undef PG8_STAGE
#undef PG8_LDA
#undef PG8_LDB
#undef PG8_MMA
#undef PG8_WAIT_V
#undef PG8_WAIT_L
#undef PG8_BAR
#undef PG8_SCHED
}
}
#include <hip/hip_bf16.h>
#include <cmath>
namespace attn_body {
using bf16=__hip_bfloat16;
using bf16x8=__attribute__((ext_vector_type(8)))short;
using s16x4=__attribute__((ext_vector_type(4)))short;
using f32x16=__attribute__((ext_vector_type(16)))float;
using u32x4=__attribute__((ext_vector_type(4)))unsigned;
constexpr int BATCH=2,NHEAD=16,SEQ=4096,LK=4352,D=64,DM=NHEAD*D;
constexpr int NW=8,QBLK=32,QB=QBLK*NW,KVBLK=64,NQB=SEQ/QB;
constexpr int ATTN_PITCH=DM, ATTN_UNIT_ROWS=QB;
__device__ __forceinline__ int crow(int r,int hi){return (r&3)+8*(r>>2)+4*hi;}
#define SBAR() __builtin_amdgcn_sched_barrier(0)
constexpr int NSLOT=3, SLOTB=8192;
constexpr int LDS_K=0, LDS_V=NSLOT*SLOTB, LDS_WS=2*NSLOT*SLOTB, LDS_OST=LDS_WS+NW*64*4, LDS_BYTES=LDS_OST+NW*4096;
constexpr float C2=0.125f*1.4426950408889634f;
__device__ __forceinline__ void glds16(const void*gsrc,unsigned lds_dst){unsigned keep;
  asm volatile("s_mov_b32 %0, m0\n\ts_mov_b32 m0, %2\n\ts_nop 0\n\tglobal_load_lds_dwordx4 %1, off\n\ts_mov_b32 m0, %0":"=&s"(keep):"v"(gsrc),"s"(lds_dst):"memory");}
__device__ __forceinline__ float max3f(float a,float b,float c){float r;asm("v_max3_f32 %0, %1, %2, %3":"=v"(r):"v"(a),"v"(b),"v"(c));return r;}
__device__ __forceinline__ float max2f(float a,float b){float r;asm("v_max_f32_e32 %0, %1, %2":"=v"(r):"v"(a),"v"(b));return r;}
__device__ __forceinline__ float fadd_s(float a,float b){float r;asm("v_add_f32_e32 %0, %1, %2":"=v"(r):"v"(a),"v"(b));return r;}
__device__ __forceinline__ float fsub_s(float a,float b){float r;asm("v_sub_f32_e32 %0, %1, %2":"=v"(r):"v"(a),"v"(b));return r;}
typedef float f32x2_t __attribute__((ext_vector_type(2))); typedef __bf16 bf16x2_t __attribute__((ext_vector_type(2)));
__device__ __forceinline__ unsigned cvtpk_s(float lo,float hi){f32x2_t v={lo,hi};bf16x2_t b=__builtin_convertvector(v,bf16x2_t);return __builtin_bit_cast(unsigned,b);}
#define WAIT_BAR(N) asm volatile("s_waitcnt vmcnt(" #N ") lgkmcnt(0)\n\ts_barrier":::"memory")

__device__ __forceinline__ void qkt(f32x16&p0,f32x16&p1,const char*Kslot,const bf16x8*qr,const f32x16&negm,int r32,int hi){
  const char*kb=Kslot+hi*1024+r32*16;
  #pragma unroll
  for(int d0=0;d0<4;++d0){
    const bf16x8 b0=*reinterpret_cast<const bf16x8*>(kb+d0*2048);
    const bf16x8 b1=*reinterpret_cast<const bf16x8*>(kb+d0*2048+512);
    if(d0==0){p0=__builtin_amdgcn_mfma_f32_32x32x16_bf16(b0,qr[0],negm,0,0,0);p1=__builtin_amdgcn_mfma_f32_32x32x16_bf16(b1,qr[0],negm,0,0,0);}
    else{p0=__builtin_amdgcn_mfma_f32_32x32x16_bf16(b0,qr[d0],p0,0,0,0);p1=__builtin_amdgcn_mfma_f32_32x32x16_bf16(b1,qr[d0],p1,0,0,0);}}
}
typedef __attribute__((address_space(3))) const char* lds_cptr;
typedef short v4i16_t __attribute__((ext_vector_type(4)));
__device__ __forceinline__ void kload8(bf16x8*kf,lds_cptr kp){
  kf[0]=*(const __attribute__((address_space(3))) bf16x8*)(kp);      kf[1]=*(const __attribute__((address_space(3))) bf16x8*)(kp+512);
  kf[2]=*(const __attribute__((address_space(3))) bf16x8*)(kp+2048); kf[3]=*(const __attribute__((address_space(3))) bf16x8*)(kp+2560);
  kf[4]=*(const __attribute__((address_space(3))) bf16x8*)(kp+4096); kf[5]=*(const __attribute__((address_space(3))) bf16x8*)(kp+4608);
  kf[6]=*(const __attribute__((address_space(3))) bf16x8*)(kp+6144); kf[7]=*(const __attribute__((address_space(3))) bf16x8*)(kp+6656);
}
__device__ __forceinline__ void kload2(bf16x8*kf,lds_cptr kp,int j){ kf[2*j]=*(const __attribute__((address_space(3))) bf16x8*)(kp+j*2048); kf[2*j+1]=*(const __attribute__((address_space(3))) bf16x8*)(kp+j*2048+512); }
__device__ __forceinline__ s16x4 vtr(lds_cptr p){ return __builtin_bit_cast(s16x4,__builtin_amdgcn_ds_read_tr16_b64_v4i16((__attribute__((address_space(3))) v4i16_t*)p)); }
__device__ __forceinline__ float rowmax(const f32x16&p0,const f32x16&p1){
  float a=max3f(p0[0],p0[1],p1[0]),b=max3f(p0[2],p0[3],p1[1]);a=max3f(a,p1[2],p1[3]);
  #pragma unroll
  for(int r=4;r<16;r+=4){a=max3f(a,p0[r],p0[r+1]);b=max3f(b,p0[r+2],p0[r+3]);a=max3f(a,p1[r],p1[r+1]);b=max3f(b,p1[r+2],p1[r+3]);}
  const float m=max2f(a,b);
  auto rr=__builtin_amdgcn_permlane32_swap(__float_as_uint(m),__float_as_uint(m),false,false);
  return max2f(__uint_as_float(rr[0]),__uint_as_float(rr[1]));
}
__device__ __forceinline__ void pv(f32x16*o,int vb,bf16x8 pa0,bf16x8 pa1,bf16x8 pa2,bf16x8 pa3){
  #pragma unroll
  for(int d0=0;d0<2;++d0){s16x4 lo[4],hi[4];
    #pragma unroll
    for(int ks=0;ks<4;++ks){
      asm volatile("ds_read_b64_tr_b16 %0,%1 offset:%c2":"=&v"(lo[ks]):"v"(vb),"i"(d0*4096+ks*1024):"memory");
      asm volatile("ds_read_b64_tr_b16 %0,%1 offset:%c2":"=&v"(hi[ks]):"v"(vb),"i"(d0*4096+ks*1024+512):"memory");}
    asm volatile("s_waitcnt lgkmcnt(0)":::"memory");SBAR();
    #define PK(k) (bf16x8){lo[k][0],lo[k][1],lo[k][2],lo[k][3],hi[k][0],hi[k][1],hi[k][2],hi[k][3]}
    o[d0]=__builtin_amdgcn_mfma_f32_32x32x16_bf16(pa0,PK(0),o[d0],0,0,0);
    o[d0]=__builtin_amdgcn_mfma_f32_32x32x16_bf16(pa1,PK(1),o[d0],0,0,0);
    o[d0]=__builtin_amdgcn_mfma_f32_32x32x16_bf16(pa2,PK(2),o[d0],0,0,0);
    o[d0]=__builtin_amdgcn_mfma_f32_32x32x16_bf16(pa3,PK(3),o[d0],0,0,0);
    #undef PK
  }
}

#ifndef ATTN_STORE16
#define ATTN_STORE16(p,v) (*(u32x4*)(p)=(v))
#endif
template<int THRL> __device__ __forceinline__ void attn_unit(const bf16*Qu,const bf16*__restrict__ Kh,const bf16*__restrict__ Vh,bf16*Ou,char*shm){
  const int tid=threadIdx.x,lane=tid&63,r32=lane&31,hi=lane>>5; const int wid=__builtin_amdgcn_readfirstlane(tid>>6);
  const bf16*Qw=Qu+(long)wid*QBLK*DM;
  const unsigned lds0=(unsigned)(uintptr_t)shm;
  float*wsf=(float*)(shm+LDS_WS)+wid*64;
  const bf16*ksrc=Kh+(long)lane*DM+wid*8;
  const bf16*vsrc=Vh+(long)(16*(wid&3)+(lane>>2))*DM+(wid>>2)*32+(lane&3)*8;
  const unsigned kdst=lds0+LDS_K+wid*1024, vdst=lds0+LDS_V+wid*1024;
  #define DMA_K(t,slot) glds16(ksrc+(long)(t)*KVBLK*DM,(unsigned)__builtin_amdgcn_readfirstlane(kdst+(slot)))
  #define DMA_V(t,slot) glds16(vsrc+(long)(t)*KVBLK*DM,(unsigned)__builtin_amdgcn_readfirstlane(vdst+(slot)))
  const int vb0=(int)(lds0+LDS_V)+((lane>>4)&1)*32+(lane&3)*8+(4*hi+((lane&15)>>2))*64;
  const char*Kbase=shm+LDS_K; bf16x8 kf[8];
  const lds_cptr shm3=(lds_cptr)shm; const lds_cptr kp0=shm3+LDS_K+hi*1024+r32*16; const lds_cptr vp0=shm3+LDS_V+((lane>>4)&1)*32+(lane&3)*8+(4*hi+((lane&15)>>2))*64;
  constexpr int NT=LK/KVBLK;
  DMA_K(0,0);DMA_V(0,0);DMA_K(1,SLOTB);
  bf16x8 qr[4];
  #pragma unroll
  for(int d0=0;d0<4;++d0)qr[d0]=*reinterpret_cast<const bf16x8*>(&Qw[(long)r32*DM+d0*16+hi*8]);
  float mhat=0.f,l_reg=0.f;f32x16 o[2];o[0]=f32x16{};o[1]=f32x16{};f32x16 negm=f32x16{};asm volatile("":"+v"(negm));
  #define CMASK(P0,P1,t) do{}while(0)
  bool resc=false;
  #define START(P0,P1) do{ const float rm=rowmax(P0,P1); resc=false; \
    { const float dl=rm; mhat=fadd_s(mhat,dl); \
      _Pragma("unroll") for(int r=0;r<16;++r){P0[r]=fsub_s(P0[r],dl);P1[r]=fsub_s(P1[r],dl);} \
      _Pragma("unroll") for(int r=0;r<16;++r)negm[r]=-mhat; asm volatile("":"+v"(negm)); } \
    _Pragma("unroll") for(int r=0;r<16;++r)P0[r]=__builtin_amdgcn_exp2f(P0[r]); }while(0)
  #define RESC() do{ if(resc){ asm volatile("s_waitcnt lgkmcnt(0)":::"memory"); \
      _Pragma("unroll") for(int d_=0;d_<2;++d_) _Pragma("unroll") for(int r=0;r<16;++r)o[d_][r]*=wsf[crow(r,hi)]; } }while(0)
  f32x16 pA0,pA1,pB0,pB1;
  int sl_prev=0,sl_cur=0,sl_next=SLOTB;
  #define ROT() do{sl_prev=sl_cur;sl_cur=sl_next;sl_next=(sl_next==(NSLOT-1)*SLOTB)?0:sl_next+SLOTB;}while(0)
  DMA_K(2,2*SLOTB);
  WAIT_BAR(3);
  qkt(pA0,pA1,Kbase,qr,negm,r32,hi);asm volatile("s_nop 15\n\ts_nop 7":"+v"(pA0),"+v"(pA1));CMASK(pA0,pA1,0);
  START(pA0,pA1);
  _Pragma("unroll") for(int r=0;r<16;++r)pA1[r]=__builtin_amdgcn_exp2f(pA1[r]);
  WAIT_BAR(0);
  DMA_K(3,0);DMA_V(1,SLOTB);
  ROT();
  kload8(kf,kp0+sl_cur);
  WAIT_BAR(2);
  s16x4 vlo[8],vhi[8]; u32x4 pw0,pw1,pw2,pw3;
  #define PKW(P,B) cvtpk_s(P[B],P[B+1])
  #define PAF(k) __builtin_bit_cast(bf16x8,pw##k)
  #define VFR(i) (bf16x8){vlo[i][0],vlo[i][1],vlo[i][2],vlo[i][3],vhi[i][0],vhi[i][1],vhi[i][2],vhi[i][3]}
  #define PIN(x) asm volatile("":"+v"(x))
  #define MX3(a,b,c) __builtin_fmaxf(__builtin_fmaxf((a),(b)),(c))
  #define GAPA(MF,A0,A1,A2,A3,W0,W1,PW) do{ MF; sacc+=A0; sacc+=A1; sacc+=A2; sacc+=A3; PIN(sacc); W0; W1; PIN(PW); SBAR(); }while(0)
  #define EX(v) __builtin_amdgcn_exp2f(v)
  #define GAPB(MF,X,B) do{ MF; X[B]=EX(X[B]); X[B+1]=EX(X[B+1]); X[B+2]=EX(X[B+2]); X[B+3]=EX(X[B+3]); PIN(X); SBAR(); }while(0)
  #define VRD(i) do{ vlo[i]=vtr(vp_+(((i)>>2)*4096+((i)&3)*1024)); vhi[i]=vtr(vp_+(((i)>>2)*4096+((i)&3)*1024+512)); }while(0)
  #define KRD(G,j) do{ if(G){ kload2(kf,kp0+sl_next,j); SBAR(); } }while(0)
  #define STEP(C0,C1,P0,P1,t,GK,GV,GL) do{ SBAR(); \
    const lds_cptr vp_=vp0+sl_prev; \
    VRD(0); SBAR(); float sacc=(P0[0]+P0[1]); \
    GAPA(C0=__builtin_amdgcn_mfma_f32_32x32x16_bf16(kf[0],qr[0],negm,0,0,0), P0[2],P0[3],P0[4],P0[5],     pw0[0]=PKW(P0,0), pw0[1]=PKW(P0,2), pw0); \
    VRD(4); SBAR(); GAPA(C1=__builtin_amdgcn_mfma_f32_32x32x16_bf16(kf[1],qr[0],negm,0,0,0), P0[6],P0[7],P0[8],P0[9],     pw0[2]=PKW(P0,4), pw0[3]=PKW(P0,6), pw0); \
    VRD(1); SBAR(); GAPA(C0=__builtin_amdgcn_mfma_f32_32x32x16_bf16(kf[2],qr[1],C0,0,0,0),   P0[10],P0[11],P0[12],P0[13], pw1[0]=PKW(P0,8), pw1[1]=PKW(P0,10), pw1); \
    VRD(5); SBAR(); GAPA(C1=__builtin_amdgcn_mfma_f32_32x32x16_bf16(kf[3],qr[1],C1,0,0,0),   P0[14],P0[15],P1[0],P1[1],   pw1[2]=PKW(P0,12),pw1[3]=PKW(P0,14), pw1); \
    VRD(2); SBAR(); GAPA(C0=__builtin_amdgcn_mfma_f32_32x32x16_bf16(kf[4],qr[2],C0,0,0,0),   P1[2],P1[3],P1[4],P1[5],     pw2[0]=PKW(P1,0), pw2[1]=PKW(P1,2), pw2); \
    VRD(6); SBAR(); GAPA(C1=__builtin_amdgcn_mfma_f32_32x32x16_bf16(kf[5],qr[2],C1,0,0,0),   P1[6],P1[7],P1[8],P1[9],     pw2[2]=PKW(P1,4), pw2[3]=PKW(P1,6), pw2); \
    VRD(3); SBAR(); GAPA(C0=__builtin_amdgcn_mfma_f32_32x32x16_bf16(kf[6],qr[3],C0,0,0,0),   P1[10],P1[11],P1[12],P1[13], pw3[0]=PKW(P1,8), pw3[1]=PKW(P1,10), pw3); \
    VRD(7); SBAR(); GAPA(C1=__builtin_amdgcn_mfma_f32_32x32x16_bf16(kf[7],qr[3],C1,0,0,0),   P1[14],P1[15],0.f,0.f,       pw3[2]=PKW(P1,12),pw3[3]=PKW(P1,14), pw3); \
    l_reg+=sacc; \
    if(GK){DMA_K((t)+3,sl_cur);} if(GV){DMA_V((t)+1,sl_next);} \
    CMASK(C0,C1,t); \
    { float a=MX3(C0[0],C0[1],C1[0]),b=MX3(C0[2],C0[3],C1[1]); a=MX3(a,C1[2],C1[3]); \
      _Pragma("unroll") for(int r=4;r<16;r+=4){a=MX3(a,C0[r],C0[r+1]);b=MX3(b,C0[r+2],C0[r+3]);a=MX3(a,C1[r],C1[r+1]);b=MX3(b,C1[r+2],C1[r+3]);} \
      float rm=__builtin_fmaxf(a,b); { auto rr=__builtin_amdgcn_permlane32_swap(__float_as_uint(rm),__float_as_uint(rm),false,false); rm=__builtin_fmaxf(__uint_as_float(rr[0]),__uint_as_float(rr[1])); } \
      resc=false; \
      if(__builtin_expect(__any(rm>(float)THRL),0)){ const float dl=__builtin_fmaxf(rm,0.f); mhat+=dl; \
        _Pragma("unroll") for(int r=0;r<16;++r){C0[r]-=dl;C1[r]-=dl;} \
        _Pragma("unroll") for(int r=0;r<16;++r)negm[r]=-mhat; asm volatile("":"+v"(negm)); \
        const float f=__builtin_amdgcn_exp2f(-dl); l_reg*=f; if(hi==0)wsf[r32]=f; resc=true; } } \
    SBAR(); \
    GAPB(o[0]=__builtin_amdgcn_mfma_f32_32x32x16_bf16(PAF(0),VFR(0),o[0],0,0,0), C0,0); \
    GAPB(o[1]=__builtin_amdgcn_mfma_f32_32x32x16_bf16(PAF(0),VFR(4),o[1],0,0,0), C0,4); \
    KRD(GL,0); GAPB(o[0]=__builtin_amdgcn_mfma_f32_32x32x16_bf16(PAF(1),VFR(1),o[0],0,0,0), C0,8); \
    KRD(GL,1); GAPB(o[1]=__builtin_amdgcn_mfma_f32_32x32x16_bf16(PAF(1),VFR(5),o[1],0,0,0), C0,12); \
    KRD(GL,2); GAPB(o[0]=__builtin_amdgcn_mfma_f32_32x32x16_bf16(PAF(2),VFR(2),o[0],0,0,0), C1,0); \
    KRD(GL,3); GAPB(o[1]=__builtin_amdgcn_mfma_f32_32x32x16_bf16(PAF(2),VFR(6),o[1],0,0,0), C1,4); \
    GAPB(o[0]=__builtin_amdgcn_mfma_f32_32x32x16_bf16(PAF(3),VFR(3),o[0],0,0,0), C1,8); \
    GAPB(o[1]=__builtin_amdgcn_mfma_f32_32x32x16_bf16(PAF(3),VFR(7),o[1],0,0,0), C1,12); \
    }while(0)
  int t=1;
  #undef CMASK
  #define CMASK(P0,P1,t) do{}while(0)
  for(;t+5<NT;t+=2){
    STEP(pB0,pB1,pA0,pA1,t,true,true,true);     WAIT_BAR(2); RESC(); ROT();
    STEP(pA0,pA1,pB0,pB1,t+1,true,true,true);   WAIT_BAR(2); RESC(); ROT();
  }
  #undef CMASK
  #define CMASK(P0,P1,t) do{}while(0)
  #define ENDW(tt) do{ if((tt)+3<NT){WAIT_BAR(2);} else if((tt)+2<NT){WAIT_BAR(1);} else {WAIT_BAR(0);} }while(0)
  for(;t+1<NT;t+=2){
    STEP(pB0,pB1,pA0,pA1,t,(t+3<NT),(t+1<NT),(t+1<NT));       ENDW(t);   RESC(); ROT();
    STEP(pA0,pA1,pB0,pB1,t+1,(t+4<NT),(t+2<NT),(t+2<NT));     ENDW(t+1); RESC(); ROT();
  }
  STEP(pB0,pB1,pA0,pA1,NT-1,false,false,false); RESC();
  { float sacc=pB0[0]+pB0[1]; _Pragma("unroll") for(int r=2;r<16;++r)sacc+=pB0[r]; _Pragma("unroll") for(int r=0;r<16;++r)sacc+=pB1[r]; l_reg+=sacc;
    pw0=(u32x4){PKW(pB0,0),PKW(pB0,2),PKW(pB0,4),PKW(pB0,6)};pw1=(u32x4){PKW(pB0,8),PKW(pB0,10),PKW(pB0,12),PKW(pB0,14)};pw2=(u32x4){PKW(pB1,0),PKW(pB1,2),PKW(pB1,4),PKW(pB1,6)};pw3=(u32x4){PKW(pB1,8),PKW(pB1,10),PKW(pB1,12),PKW(pB1,14)};
    SBAR(); pv(o,vb0+sl_cur,PAF(0),PAF(1),PAF(2),PAF(3)); }
  #undef PKW
  #undef PAF
  #undef VFR
  #undef PIN
  #undef MX3
  #undef GAPA
  #undef GAPB
  #undef EX
  #undef VRD
  #undef KRD
  #undef STEP
  #undef ENDW
  {auto rr=__builtin_amdgcn_permlane32_swap(__float_as_uint(l_reg),__float_as_uint(l_reg),false,false);l_reg=__uint_as_float(rr[0])+__uint_as_float(rr[1]);}
  if(hi==0)wsf[32+r32]=l_reg;asm volatile("s_waitcnt lgkmcnt(0)":::"memory");
  float rli[16];
  #pragma unroll
  for(int r=0;r<16;++r)rli[r]=__builtin_amdgcn_rcpf(wsf[32+crow(r,hi)]);
  bf16*Ow=Ou+(long)wid*QBLK*DM;
  { bf16*stg=(bf16*)(shm+LDS_OST)+wid*2048;
    #pragma unroll
    for(int r=0;r<16;++r){const int orow=crow(r,hi);
      #pragma unroll
      for(int d0=0;d0<2;++d0)stg[orow*64+d0*32+r32]=__float2bfloat16(o[d0][r]*rli[r]);}
    asm volatile("s_waitcnt lgkmcnt(0)":::"memory");
    #pragma unroll
    for(int i=0;i<4;++i){const int row=i*8+(lane>>3),ch=lane&7; const u32x4 v=*(const u32x4*)(stg+row*64+ch*8); ATTN_STORE16(Ow+(long)row*DM+ch*8,v);} }
  asm volatile("s_waitcnt lgkmcnt(0)\n\ts_barrier":::"memory");
  #undef DMA_K
  #undef DMA_V
  #undef CMASK
  #undef START
  #undef RESC
  #undef ROT
}
constexpr int ATTN_LDS_BYTES=LDS_BYTES;
#undef SBAR
#undef WAIT_BAR
}
#define GAS __attribute__((address_space(1)))
#define LAS __attribute__((address_space(3)))
typedef unsigned short bf16;
typedef unsigned v4u __attribute__((ext_vector_type(4)));
typedef float f32x4 __attribute__((ext_vector_type(4)));
typedef short bf16x8 __attribute__((ext_vector_type(8)));
typedef GAS unsigned gu32;
typedef GAS unsigned long long gu64;
#define RLX_AGENT __ATOMIC_RELAXED, __HIP_MEMORY_SCOPE_AGENT
#define LDS_WAIT() asm volatile("s_waitcnt lgkmcnt(0)" ::: "memory")
#define VM_WAIT() asm volatile("s_waitcnt vmcnt(0)" ::: "memory")
__device__ __forceinline__ unsigned long long rt() { return __builtin_amdgcn_s_memrealtime(); }
__device__ __forceinline__ unsigned f2bf(float f) { unsigned u = __builtin_bit_cast(unsigned, f); return (u + 0x7fffu + ((u >> 16) & 1u)) >> 16; }
__device__ __forceinline__ unsigned pk2(float lo, float hi) { return f2bf(lo) | (f2bf(hi) << 16); }

#define XB_TMO      128
#define XB_XCNT(j)  (256  + 64 * (j))
#define XB_XSUB(j)  (1280 + 64 * (j))
#define XB_XGEN(j)  (2304 + 64 * (j))
#define XB_TOP      3328
#define XB_TOPGEN   3392
#define XCD_BAR_WORDS 3456
#define XB_SPIN_CAP (1u << 18)

__device__ __forceinline__ unsigned xb_ld(unsigned* p)              { return __hip_atomic_load(p, __ATOMIC_RELAXED, __HIP_MEMORY_SCOPE_AGENT); }
__device__ __forceinline__ unsigned xb_add(unsigned* p, unsigned v) { return __hip_atomic_fetch_add(p, v, __ATOMIC_RELAXED, __HIP_MEMORY_SCOPE_AGENT); }
__device__ __forceinline__ unsigned xb_xcc_id() { return (unsigned)__builtin_amdgcn_s_getreg((3 << 11) | 20) & 0xFu; }
#define XB_SPIN(cond, bar) do { unsigned _sp = 0; while (cond) { __builtin_amdgcn_s_sleep(1); \
    if ((++_sp & 255u) == 0u) { if (xb_ld(&(bar)[XB_TMO])) break; if (_sp > XB_SPIN_CAP) { atomicAdd(&(bar)[XB_TMO], 1u); break; } } } } while (0)

struct XcdBarrier {
    unsigned* bar; unsigned x;
    volatile LAS unsigned* st;
};

__device__ __forceinline__ XcdBarrier xcd_barrier_post(unsigned* bar, volatile LAS unsigned* st) {
    XcdBarrier b; b.bar = bar; b.x = xb_xcc_id(); b.st = st;
    if (threadIdx.x == 0) (void)xb_add(&bar[XB_XCNT(b.x)], 1u);
    return b;
}
__device__ __forceinline__ void xcd_barrier_complete(unsigned* bar, unsigned x, unsigned& nloc, unsigned& nx) {
    const unsigned G = gridDim.x * gridDim.y * gridDim.z;
    unsigned sum, cnt, mine, sp = 0u;
    for (;;) {
        sum = 0u; cnt = 0u; mine = 0u;
#pragma unroll
        for (unsigned j = 0; j < 16; ++j) { const unsigned c = xb_ld(&bar[XB_XCNT(j)]); sum += c; cnt += (c > 0u) ? 1u : 0u; mine = (j == x) ? c : mine; }
        if (sum == G) break;
        __builtin_amdgcn_s_sleep(1);
        if ((++sp & 255u) == 0u) { if (xb_ld(&bar[XB_TMO])) break; if (sp > XB_SPIN_CAP) { atomicAdd(&bar[XB_TMO], 1u); break; } }
    }
    nloc = mine > 0u ? mine : 1u; nx = cnt > 0u ? cnt : 1u;
}

__device__ __forceinline__ void xcd_barrier(const XcdBarrier& b) {
    asm volatile("s_waitcnt vmcnt(0)" ::: "memory");
    __syncthreads();
    if (threadIdx.x == 0) {
        unsigned* bar = b.bar;
        __builtin_amdgcn_s_waitcnt(0);
        unsigned nloc = b.st[0], nx = b.st[1];
        if (nloc == 0u) { xcd_barrier_complete(bar, b.x, nloc, nx); b.st[0] = nloc; b.st[1] = nx; }
        const unsigned old = xb_add(&bar[XB_XSUB(b.x)], 1u);
        const unsigned gen = old / nloc;
        if (old + 1u == (gen + 1u) * nloc) {
            __builtin_amdgcn_fence(__ATOMIC_RELEASE, "agent");
            asm volatile("s_waitcnt vmcnt(0)" ::: "memory");
            const unsigned og = xb_add(&bar[XB_TOP], 1u);
            const unsigned tg = og / nx;
            if (og + 1u == (tg + 1u) * nx) xb_add(&bar[XB_TOPGEN], 1u);
            else XB_SPIN(xb_ld(&bar[XB_TOPGEN]) == tg, bar);
            __builtin_amdgcn_fence(__ATOMIC_ACQUIRE, "agent");
            xb_add(&bar[XB_XGEN(b.x)], 1u);
            asm volatile("s_waitcnt vmcnt(0)" ::: "memory");
        } else {
            XB_SPIN(xb_ld(&bar[XB_XGEN(b.x)]) == gen, bar);
            __builtin_amdgcn_fence(__ATOMIC_ACQUIRE, "agent");
            asm volatile("s_waitcnt vmcnt(0)" ::: "memory");
        }
    }
    __syncthreads();
}
__device__ __forceinline__ float wave_sum(float v) {
#pragma unroll
    for (int o = 1; o < 64; o <<= 1) v += __shfl_xor(v, o);
    return v;
}
__device__ __forceinline__ void p0_transpose_item(const float* W, int K, int N, bf16* WT, LAS float* scr, int item, int lane) {
    const int nblk = N / 32, kb = item / nblk, nb = item % nblk, k0 = 64 * kb, n0 = 32 * nb;
#pragma unroll 8
    for (int i = 0; i < 32; ++i) { const int kk = 2 * i + (lane >> 5); scr[kk * 33 + (lane & 31)] = W[(size_t)(k0 + kk) * N + n0 + (lane & 31)]; }
    LDS_WAIT(); asm volatile("" ::: "memory");
    const int c = lane & 7;
#pragma unroll
    for (int j = 0; j < 4; ++j) { const int n = (lane >> 3) + 8 * j; const LAS float* s = scr + (8 * c) * 33 + n;
        v4u o; o.x = pk2(s[0 * 33], s[1 * 33]); o.y = pk2(s[2 * 33], s[3 * 33]); o.z = pk2(s[4 * 33], s[5 * 33]); o.w = pk2(s[6 * 33], s[7 * 33]);
        *(GAS v4u*)(WT + (size_t)(n0 + n) * K + k0 + 8 * c) = o; }
    LDS_WAIT(); asm volatile("" ::: "memory");
}
__device__ __forceinline__ void norm_mod_row(const float* xrow, const float* g, const float* sh, const float* sc, bf16* orow, int lane) {
    const GAS f32x4* xr = (const GAS f32x4*)xrow + lane;
    f32x4 v[8]; float s = 0.f;
#pragma unroll
    for (int j = 0; j < 8; ++j) { v[j] = xr[64 * j]; s += (v[j].x * v[j].x + v[j].y * v[j].y) + (v[j].z * v[j].z + v[j].w * v[j].w); }
    const float rstd = 1.f / sqrtf(wave_sum(s) * (1.f / DM_) + EPS_);
    GAS unsigned long long* o8 = (GAS unsigned long long*)orow + lane;
#pragma unroll
    for (int j = 0; j < 8; ++j) { const f32x4 gg = ((const GAS f32x4*)g)[64 * j + lane], hh = ((const GAS f32x4*)sh)[64 * j + lane], cc = ((const GAS f32x4*)sc)[64 * j + lane];
        const f32x4 y = v[j] * rstd * gg * (cc + 1.0f) + hh;
        o8[64 * j] = (unsigned long long)pk2(y.x, y.y) | ((unsigned long long)pk2(y.z, y.w) << 32); }
}

struct Args { const float* in[20]; float* out; unsigned char* ws; int ph_lo, ph_hi, li, coop; };
__global__ void __launch_bounds__(NWAVES * 64, 2) mk_fwd(Args args) {
    extern __shared__ __attribute__((aligned(16))) unsigned char lds[];
    LAS unsigned char* const ldsp = (LAS unsigned char*)lds;
    volatile LAS unsigned* MISC = (volatile LAS unsigned*)(ldsp + MISC_OFF);
    const int tid = threadIdx.x, lane = tid & 63, wave = __builtin_amdgcn_readfirstlane(tid >> 6);
    const int G = gridDim.x, bx = blockIdx.x; const int vcu = (G % 8 == 0) ? (bx % 8) * (G / 8) + bx / 8 : bx;
    unsigned char* ws = args.ws;
    gu32* ctl = (gu32*)(ws + WS_CTL);
    const float *x = args.in[0], *cvec = args.in[1], *ctxp = args.in[2], *c_ctx = args.in[3], *w_ada = args.in[4], *b_ada = args.in[5], *g_norm1 = args.in[6], *w_in = args.in[7],
                *lam_q1 = args.in[8], *lam_k1 = args.in[9], *lam_q2 = args.in[10], *lam_k2 = args.in[11], *g_subln = args.in[12], *w_attn_br = args.in[13], *w_four_br = args.in[14],
                *w_out = args.in[15], *g_norm2 = args.in[16], *w_mlp_in = args.in[17], *w_mlp_out = args.in[18], *g_final = args.in[19];
    float* out = args.out;
    float* MOD = (float*)(ws + WS_MOD);
    for (int u = tid; u < (LDS_BYTES - LDSCTL_OFF) / 4; u += NWAVES * 64) ((LAS unsigned*)(ldsp + LDSCTL_OFF))[u] = 0u;
    __syncthreads();
    XcdBarrier bar = xcd_barrier_post((unsigned*)(ctl + CW_BAR) + args.li * XCD_BAR_WORDS, MISC + 8);
    const int lo = args.ph_lo, hi = args.ph_hi;
#ifndef PHMASK
#define PHMASK 0xfff
#endif
#define IN(k) ((((PHMASK) >> (k)) & 1) && lo <= (k) && (k) < hi)
#define SEAM(k) do { if (IN(k) && IN((k) + 1)) xcd_barrier(bar); } while (0)
    const int gw = bx * NWAVES + wave, NGW = G * NWAVES, gt = bx * (NWAVES * 64) + tid, NGT = G * NWAVES * 64;

    if (IN(0)) {
        LAS float* scr = (LAS float*)(ldsp + RING_OFF + wave * 16384);
        constexpr int I_IN = (DM_ / 64) * (INCOLS / 32), I_AT = (1024 / 64) * (DM_ / 32), I_OUT = (DM_ / 64) * (DM_ / 32);
        constexpr int NITEMS = I_IN + 2 * I_AT + I_OUT;
        for (int it = gw; it < NITEMS; it += NGW) {
            int r = it;
            if (r < I_IN) { p0_transpose_item(w_in, DM_, INCOLS, (bf16*)(ws + WS_WIN), scr, r, lane); continue; } r -= I_IN;
            if (r < I_AT) { p0_transpose_item(w_attn_br, 1024, DM_, (bf16*)(ws + WS_WATT), scr, r, lane); continue; } r -= I_AT;
            if (r < I_AT) { p0_transpose_item(w_four_br, 1024, DM_, (bf16*)(ws + WS_WFOUR), scr, r, lane); continue; } r -= I_AT;
            p0_transpose_item(w_out, DM_, DM_, (bf16*)(ws + WS_WOUT), scr, r, lane);
        }
        { bf16* D = (bf16*)(ws + WS_DFTM);
          for (int idx = gt; idx < 4096 * 512; idx += NGT) { const int lp = idx >> 9, l0 = (idx & 511) * 8; float cv[8], sv[8];
#pragma unroll
              for (int e = 0; e < 8; ++e) { const int j = (lp * (l0 + e)) & 4095; const float xx = (float)j * (1.0f / 2048.0f); cv[e] = cospif(xx); sv[e] = sinpif(xx); }
              v4u oc, os; oc.x = pk2(cv[0], cv[1]); oc.y = pk2(cv[2], cv[3]); oc.z = pk2(cv[4], cv[5]); oc.w = pk2(cv[6], cv[7]);
              os.x = pk2(sv[0], sv[1]); os.y = pk2(sv[2], sv[3]); os.z = pk2(sv[4], sv[5]); os.w = pk2(sv[6], sv[7]);
              *(GAS v4u*)(D + (size_t)lp * 8192 + l0) = oc; *(GAS v4u*)(D + (size_t)lp * 8192 + 4096 + l0) = os; } }
        { bf16* CS = (bf16*)(ws + WS_CS);
          for (int idx = gt; idx < 512 * 256; idx += NGT) { const int mrow = idx >> 8, cc = idx & 255, n = mrow & 255; const float xx = (float)((n * cc) & 255) * (1.0f / 128.0f);
              CS[idx] = (bf16)f2bf((mrow >> 8) ? sinpif(xx) : cospif(xx)); } }
        { float* rc = (float*)(ws + WS_ROPEC); float* rs = (float*)(ws + WS_ROPES);
          for (int idx = gt; idx < 1024; idx += NGT) { const int pos = idx >> 4, j = idx & 15; const float inv = powf(10000.0f, -(float)(2 * j) / 32.0f); const float ang = (float)pos * inv; rc[idx] = cosf(ang); rs[idx] = sinf(ang); } }
        for (int t = gt; t < 32 * 3072; t += NGT) { const int cgp = t % 3072, kc = t / 3072, kbase = kc * 64;
            float c0 = cvec[kbase + lane], c1 = cvec[2048 + kbase + lane], c2 = c_ctx[kbase + lane];
            c0 = c0 / (1.f + __expf(-c0)); c1 = c1 / (1.f + __expf(-c1)); c2 = c2 / (1.f + __expf(-c2));
            f32x4 a0 = {0.f, 0.f, 0.f, 0.f}, a1 = a0, a2 = a0;
            const float* wp = w_ada + (size_t)kbase * NMOD + cgp * 4;
#pragma unroll 8
            for (int kk = 0; kk < 64; ++kk) { const f32x4 w = *(const GAS f32x4*)(wp + (size_t)kk * NMOD);
                const float s0 = __shfl(c0, kk), s1 = __shfl(c1, kk), s2 = __shfl(c2, kk); a0 += w * s0; a1 += w * s1; a2 += w * s2; }
            if (kc == 0) { const f32x4 bb = *(const GAS f32x4*)(b_ada + cgp * 4); a0 += bb; a1 += bb; a2 += bb; }
#pragma unroll
            for (int j = 0; j < 4; ++j) { atomicAdd(MOD + cgp * 4 + j, a0[j]); atomicAdd(MOD + NMOD + cgp * 4 + j, a1[j]); atomicAdd(MOD + 2 * NMOD + cgp * 4 + j, a2[j]); }
        }
        if (IN(1)) { if (args.coop) cg::this_grid().sync(); else xcd_barrier(bar); }
    }
    if (IN(1)) {
        bf16* XN = (bf16*)(ws + WS_XN);
        for (int m = gw; m < MTOK + MCTX; m += NGW) {
            const float* src = m < MTOK ? x + (size_t)m * DM_ : ctxp + (size_t)(m - MTOK) * DM_;
            const float* md = MOD + (size_t)(m < MTOK ? (m >> 12) : 2) * NMOD;
            norm_mod_row(src, g_norm1, md, md + DM_, XN + (size_t)m * DM_, lane);
        }
        SEAM(1);
    }
    if (IN(2)) {
        pg8::Gemm g{ws, DM_, DM_, DM_}; pg8::SchedG1 S; S.mp.init(32, 32); S.G = G; S.c = bx; S.offA = WS_XN; S.offB = WS_WIN;
        pg8::EpiG1 E{ws, (const float*)(ws + WS_ROPEC), (const float*)(ws + WS_ROPES)};
        pg8::gemm_phase<pg8::EpiG1, pg8::SchedG1, true, true>(ldsp + RING_OFF, g, S, E);
        SEAM(2);
    }
    if (IN(3)) {
        pg8::Gemm g{ws, 256, 1024, 256}; pg8::SchedF1 S{G, bx, WS_CS, WS_F};
        pg8::EpiF1 E{(bf16*)(ws + WS_TT)};
        pg8::gemm_phase<pg8::EpiF1, pg8::SchedF1, true, true>(ldsp + RING_OFF, g, S, E);
        SEAM(3);
    }
    if (IN(4)) {
        const attn_body::bf16 *Qb = (const attn_body::bf16*)(ws + WS_Q), *Kb = (const attn_body::bf16*)(ws + WS_K), *Vb = (const attn_body::bf16*)(ws + WS_V);
        for (int i = 0; ; ++i) { const int L = i * G + vcu; if (L >= 1024) break;
            const int prob = (L & 255) >> 2, qb = ((L >> 8) << 2) | (L & 3), b = prob >> 5, h = (prob >> 2) & 7, c = (prob >> 1) & 1, e = prob & 1;
            attn_body::bf16* Ob = (attn_body::bf16*)(ws + WS_O0 + (size_t)c * (WS_O1 - WS_O0));
            attn_body::attn_unit<8>(Qb + ((size_t)(b * SEQ_ + qb * 256)) * 1024 + (h * 2 + c) * 64, Kb + (size_t)b * 4352 * 1024 + (h * 2 + c) * 64, Vb + (size_t)b * 4352 * 1024 + (h * 2 + e) * 64,
                                    Ob + ((size_t)(b * SEQ_ + qb * 256)) * 1024 + (h * 2 + e) * 64, (char*)lds + RING_OFF);
        }
        asm volatile("s_waitcnt vmcnt(0) lgkmcnt(0)" ::: "memory"); __syncthreads();
        pg8::Gemm g{ws, 8192, 8192, 4096}; pg8::SchedF2 S{G, bx, WS_DFTM, WS_TT};
        pg8::EpiF2 E{(float*)(ws + WS_WIN), (size_t)(WS_XN - WS_WIN) / 4};
        pg8::gemm_phase<pg8::EpiF2, pg8::SchedF2, true, true>(ldsp + RING_OFF, g, S, E);
        SEAM(4);
    }
    if (IN(5)) {
        const float lam = __expf(wave_sum(lam_q1[lane] * lam_k1[lane])) - __expf(wave_sum(lam_q2[lane] * lam_k2[lane])) + LAM_INIT;
        const bf16 *O0 = (const bf16*)(ws + WS_O0), *O1 = (const bf16*)(ws + WS_O1); bf16 *AA = (bf16*)(ws + WS_AATT), *YB = (bf16*)(ws + WS_YB);
        const float *Yc = (const float*)(ws + WS_WIN), *Ys = (const float*)(ws + WS_XN);
        f32x4 gs[4];
#pragma unroll
        for (int j = 0; j < 4; ++j) gs[j] = ((const GAS f32x4*)g_subln)[(lane & 7) * 4 + j] * (1.0f - LAM_INIT);
        for (int m = gw; m < MTOK; m += NGW) {
            const size_t off = (size_t)m * 1024 + lane * 16;
            const v4u a0 = *(const GAS v4u*)(O0 + off), a1 = *(const GAS v4u*)(O0 + off + 8), b0 = *(const GAS v4u*)(O1 + off), b1 = *(const GAS v4u*)(O1 + off + 8);
            f32x4 o[4], p[4]; pg8::unpack8(a0, o[0], o[1]); pg8::unpack8(a1, o[2], o[3]); pg8::unpack8(b0, p[0], p[1]); pg8::unpack8(b1, p[2], p[3]);
            float ss = 0.f;
#pragma unroll
            for (int j = 0; j < 4; ++j) { o[j] = o[j] - p[j] * lam; ss += (o[j].x * o[j].x + o[j].y * o[j].y) + (o[j].z * o[j].z + o[j].w * o[j].w); }
            ss += __shfl_xor(ss, 1); ss += __shfl_xor(ss, 2); ss += __shfl_xor(ss, 4);
            const float r = 1.f / sqrtf(ss * (1.f / 128.f) + EPS_);
#pragma unroll
            for (int j = 0; j < 4; ++j) o[j] = o[j] * r * gs[j];
            *(GAS v4u*)(AA + off) = pg8::pack8(o[0], o[1]); *(GAS v4u*)(AA + off + 8) = pg8::pack8(o[2], o[3]);
            f32x4 y[4];
#pragma unroll
            for (int j = 0; j < 4; ++j) y[j] = (*(const GAS f32x4*)(Yc + off + 4 * j) - *(const GAS f32x4*)(Ys + off + 4 * j)) * (1.0f / 1024.0f);
            *(GAS v4u*)(YB + off) = pg8::pack8(y[0], y[1]); *(GAS v4u*)(YB + off + 8) = pg8::pack8(y[2], y[3]);
        }
        SEAM(5);
    }
    if (IN(6)) {
        pg8::Gemm g{ws, 1024, 1024, 1024}; pg8::SchedMerged S; S.mp.init(32, 8); S.G = G; S.c = bx; S.offA0 = WS_AATT; S.offB0 = WS_WATT; S.offA1 = WS_YB; S.offB1 = WS_WFOUR;
        pg8::EpiMerged E{(const bf16*)(ws + WS_SGA), (const bf16*)(ws + WS_SGF), (bf16*)(ws + WS_TT)};
        pg8::gemm_phase<pg8::EpiMerged, pg8::SchedMerged, true, true>(ldsp + RING_OFF, g, S, E);
        SEAM(6);
    }
    if (IN(7)) {
        pg8::Gemm g{ws, DM_, DM_, DM_}; pg8::SchedTiles S; S.mp.init(32, 8); S.G = G; S.c = bx; S.offA = WS_TT; S.offB = WS_WOUT; S.tA = (size_t)256 * DM_ * 2; S.tB = (size_t)256 * DM_ * 2;
        pg8::EpiRes E{x, (float*)(ws + WS_DFTM), MOD + 2 * DM_};
        pg8::gemm_phase<pg8::EpiRes, pg8::SchedTiles, true, true>(ldsp + RING_OFF, g, S, E);
        SEAM(7);
    }
    if (IN(8)) {
        bf16* XN = (bf16*)(ws + WS_XN); const float* xm = (const float*)(ws + WS_DFTM);
        for (int m = gw; m < MTOK; m += NGW) { const float* md = MOD + (size_t)(m >> 12) * NMOD; norm_mod_row(xm + (size_t)m * DM_, g_norm2, md + 3 * DM_, md + 4 * DM_, XN + (size_t)m * DM_, lane); }
        LAS float* scr = (LAS float*)(ldsp + RING_OFF + wave * 16384);
        constexpr int I_1 = (DM_ / 64) * (DFF / 32), I_2 = (DFF / 64) * (DM_ / 32);
        for (int it = gw; it < I_1 + I_2; it += NGW) {
            if (it < I_1) p0_transpose_item(w_mlp_in, DM_, DFF, (bf16*)(ws + WS_WIN), scr, it, lane);
            else p0_transpose_item(w_mlp_out, DFF, DM_, (bf16*)(ws + WS_TT), scr, it - I_1, lane);
        }
        SEAM(8);
    }
    if (IN(9)) {
        pg8::Gemm g{ws, DM_, DM_, DM_}; pg8::SchedTiles S; S.mp.init(32, 32); S.G = G; S.c = bx; S.offA = WS_XN; S.offB = WS_WIN; S.tA = (size_t)256 * DM_ * 2; S.tB = (size_t)256 * DM_ * 2;
        pg8::EpiRelu2 E{(bf16*)(ws + WS_Z)};
        pg8::gemm_phase<pg8::EpiRelu2, pg8::SchedTiles, true, true>(ldsp + RING_OFF, g, S, E);
        SEAM(9);
    }
    if (IN(10)) {
        pg8::Gemm g{ws, DFF, DFF, DFF}; pg8::SchedTiles S; S.mp.init(32, 8); S.G = G; S.c = bx; S.offA = WS_Z; S.offB = WS_TT; S.tA = (size_t)256 * DFF * 2; S.tB = (size_t)256 * DFF * 2;
        pg8::EpiRes E{(const float*)(ws + WS_DFTM), out, MOD + 5 * DM_};
        pg8::gemm_phase<pg8::EpiRes, pg8::SchedTiles, true, true>(ldsp + RING_OFF, g, S, E);
        SEAM(10);
    }
    if (IN(11)) {
        for (int m = gw; m < MTOK; m += NGW) {
            GAS f32x4* xr = (GAS f32x4*)(out + (size_t)m * DM_) + lane;
            f32x4 v[8]; float s = 0.f;
#pragma unroll
            for (int j = 0; j < 8; ++j) { v[j] = xr[64 * j]; s += (v[j].x * v[j].x + v[j].y * v[j].y) + (v[j].z * v[j].z + v[j].w * v[j].w); }
            const float rstd = 1.f / sqrtf(wave_sum(s) * (1.f / DM_) + EPS_);
#pragma unroll
            for (int j = 0; j < 8; ++j) xr[64 * j] = v[j] * rstd * ((const GAS f32x4*)g_final)[64 * j + lane];
        }
    }
#undef IN
#undef SEAM
}

constexpr int NPHASE = 12;
extern "C" void kernel_launch(void* const* d_in, const int* in_sizes, int n_in, void* d_out, int out_size, void* d_ws, size_t ws_size, hipStream_t stream) {
    static int grid = 0;
    if (grid == 0) {
        if (n_in != 20 || in_sizes[0] != MTOK * DM_ || out_size != MTOK * DM_ || ws_size < WS_END) { fprintf(stderr, "kernel_launch: unexpected shapes / workspace (n_in %d, in0 %d, out %d, ws %zu, need %zu)\n", n_in, n_in > 0 ? in_sizes[0] : -1, out_size, ws_size, (size_t)WS_END); grid = -1; return; }
        int dev = 0, cus = 0, per_cu = 0;
        if (hipGetDevice(&dev) != hipSuccess || hipDeviceGetAttribute(&cus, hipDeviceAttributeMultiprocessorCount, dev) != hipSuccess) { fprintf(stderr, "kernel_launch: device query failed\n"); grid = -1; return; }
        if (hipFuncSetAttribute((const void*)mk_fwd, hipFuncAttributeMaxDynamicSharedMemorySize, LDS_BYTES) != hipSuccess) { fprintf(stderr, "kernel_launch: hipFuncSetAttribute failed\n"); grid = -1; return; }
        if (hipOccupancyMaxActiveBlocksPerMultiprocessor(&per_cu, (const void*)mk_fwd, NWAVES * 64, LDS_BYTES) != hipSuccess || per_cu < 1) { fprintf(stderr, "kernel_launch: occupancy query says %d blocks per CU\n", per_cu); per_cu = 1; }
        (void)hipGetLastError();
        grid = cus;
    }
    if (grid < 0) return;
    if (hipMemsetAsync((char*)d_ws + WS_CTL, 0, CTL_ZERO_BYTES, stream) != hipSuccess) { fprintf(stderr, "kernel_launch: memset failed\n"); return; }
    Args a{};
    for (int i = 0; i < 20; ++i) a.in[i] = (const float*)d_in[i];
    a.out = (float*)d_out; a.ws = (unsigned char*)d_ws; a.ph_lo = 0; a.ph_hi = NPHASE; a.li = 0; a.coop = 1;
    void* kargs[] = {&a};
    const hipError_t le = hipLaunchCooperativeKernel((const void*)mk_fwd, dim3(grid), dim3(NWAVES * 64), kargs, LDS_BYTES, stream);
    if (le != hipSuccess) fprintf(stderr, "kernel_launch: cooperative launch failed: %s (grid %d)\n", hipGetErrorString(le), grid);
}
```

```cpp
#include <hip/hip_cooperative_groups.h>
namespace cg = cooperative_groups;
#include <cstddef>
constexpr int NWAVES = 8;
constexpr int DM_ = 2048, SEQ_ = 4096, BATCH_ = 2, CTXL = 256, MTOK = BATCH_ * SEQ_  , MCTX = BATCH_ * CTXL  , INCOLS = 8192, DFF = 8192, NMOD = 6 * DM_  ;
constexpr float EPS_ = 1e-6f, LAM_INIT = 0.2f;
constexpr size_t MiB = 1u << 20;
constexpr size_t WS_CTL = 0, CTL_ZERO_BYTES = 1 * MiB;
constexpr size_t WS_MOD = 256 * 1024;
constexpr size_t WS_ROWSQ1 = 512 * 1024, WS_ROWSQ2 = 576 * 1024;
constexpr size_t WS_Y2048 = 1 * MiB + 384 * 1024;
constexpr size_t WS_YC = 50 * MiB, WS_YS = 66 * MiB;
constexpr size_t WS_MB = 84 * MiB;
constexpr size_t WS_XMID = 310 * MiB;
constexpr size_t WS_ROPEC = 1 * MiB, WS_ROPES = 1 * MiB + 4096, WS_CS = 1 * MiB + 65536;
constexpr size_t WS_WATT = 2 * MiB, WS_WFOUR = 6 * MiB, WS_WOUT = 10 * MiB;
constexpr size_t WS_WIN = 18 * MiB;
constexpr size_t WS_XN = 50 * MiB;
constexpr size_t WS_DFTM = 84 * MiB;
constexpr size_t WS_Q = 148 * MiB, WS_K = 164 * MiB, WS_V = 181 * MiB, WS_F = 198 * MiB, WS_SGA = 214 * MiB, WS_SGF = 246 * MiB;
constexpr size_t WS_AATT = WS_Q, WS_YB = WS_K, WS_Z = WS_Q;
constexpr size_t WS_TT = 278 * MiB;
constexpr size_t WS_O0 = 310 * MiB, WS_O1 = 326 * MiB;
constexpr size_t WS_FE = WS_O0, WS_FO = WS_O1;
constexpr int FKC = 2176, FKS = 2048, FKP = FKC + FKS;
constexpr size_t WS_PART = 342 * MiB, WS_END = 374 * MiB;
constexpr int CW_BAR = 4096;
constexpr int RING_OFF = 0, RING_BYTES = 131072;
constexpr int LDSCTL_OFF = RING_BYTES, MISC_OFF = LDSCTL_OFF + 320;
constexpr int LDS_BYTES = 147456;
static_assert(MISC_OFF + 128 <= LDS_BYTES, "LDS map");
#include <hip/hip_runtime.h>
#include <cstdio>
#include <cstdint>
namespace pg8 {
#define PG8_LAS __attribute__((address_space(3)))
typedef unsigned short bf16_t;
typedef short bf16x8 __attribute__((ext_vector_type(8)));
typedef float f32x4 __attribute__((ext_vector_type(4)));
typedef unsigned u32x4 __attribute__((ext_vector_type(4)));
constexpr int BM = 256, BK = 64, HALF = 128, HTB = HALF * BK * 2  , STAGE_BYTES = 8 * HTB, NXCD = 8, WGM = 8;

__host__ __device__ __forceinline__ int lds_byte(int r, int c) { const int st = (r >> 4) * 2 + (c >> 5), rr = r & 15, cc = c & 31, ob = rr * 64 + cc * 2; return st * 1024 + (ob ^ (((ob >> 9) & 1) << 5)); }
__host__ __device__ __forceinline__ void stage_rc(int b, int& R, int& C) { const int st = b / 1024, sb = b % 1024, swz = sb ^ (((sb >> 9) & 1) << 5); R = (st >> 1) * 16 + swz / 64; C = (st & 1) * 32 + (swz % 64) / 2; }
__host__ __device__ __forceinline__ int perm32(int rho) { const int n = rho >> 4, i = rho & 15; return 8 * (i >> 2) + 4 * n + (i & 3); }

struct Unit { int pm, pn, z, nt; size_t aoff, boff; };
struct Gemm { const unsigned char* base; int lda, ldb, K; };
__device__ __forceinline__ unsigned cvt_pk_bf16(float lo, float hi) { unsigned r; asm volatile("v_cvt_pk_bf16_f32 %0, %1, %2" : "=v"(r) : "v"(lo), "v"(hi)); return r; }
__device__ __forceinline__ u32x4 pack8(const f32x4 v0, const f32x4 v1) { u32x4 w; w.x = cvt_pk_bf16(v0[0], v0[1]); w.y = cvt_pk_bf16(v0[2], v0[3]); w.z = cvt_pk_bf16(v1[0], v1[1]); w.w = cvt_pk_bf16(v1[2], v1[3]); return w; }
__device__ __forceinline__ void st16_nt(void* p, const u32x4 v) { __builtin_nontemporal_store(v, (u32x4*)p); }
__device__ __forceinline__ void unpack8(const u32x4 w, f32x4& v0, f32x4& v1) {
    v0[0] = __uint_as_float(w.x << 16); v0[1] = __uint_as_float(w.x & 0xffff0000u); v0[2] = __uint_as_float(w.y << 16); v0[3] = __uint_as_float(w.y & 0xffff0000u);
    v1[0] = __uint_as_float(w.z << 16); v1[1] = __uint_as_float(w.z & 0xffff0000u); v1[2] = __uint_as_float(w.w << 16); v1[3] = __uint_as_float(w.w & 0xffff0000u); }

struct Map2D {
    int nM, nN, nwg;
    __device__ __forceinline__ void init(int nM_, int nN_) { nM = nM_; nN = nN_; nwg = nM_ * nN_; }
    __device__ __forceinline__ void map(int L, int& pm, int& pn) const {
        int wgid = L; { const int q = nwg / NXCD, r = nwg % NXCD, xcd = wgid % NXCD, off = wgid / NXCD; wgid = (xcd < r ? xcd * (q + 1) : r * (q + 1) + (xcd - r) * q) + off; }
        const int nig = WGM * nN, gid = wgid / nig, fm = gid * WGM, gsz = (nM - fm) < WGM ? (nM - fm) : WGM;
        pm = fm + ((wgid % nig) % gsz); pn = (wgid % nig) / gsz;
    }
};
struct SchedTiles {
    Map2D mp; int G, c, nt; size_t offA, offB, tA, tB;
    __device__ __forceinline__ bool next(int i, Unit& u) const { const int L = i * G + c; if (L >= mp.nwg) return false; mp.map(L, u.pm, u.pn); u.z = 0; u.nt = nt; u.aoff = offA + (size_t)u.pm * tA; u.boff = offB + (size_t)u.pn * tB; return true; }
};
struct SchedG1 {
    Map2D mp; int G, c; size_t offA, offB;
    __device__ __forceinline__ bool next(int i, Unit& u) const { const int L = i * G + c;
        int kq = 0;
        if (L < 1024) { mp.map(L, u.pm, u.pn); u.z = 0; u.nt = 32;
            { const int xi = (u.pn >> 4) * 4 + ((u.pn >> 2) & 3), r = ((u.pn >> 2) + u.pn) & 3; u.pn = r == 0 ? xi : (r == 1 ? 8 + xi : 16 + xi * 2 + (r & 1)); } }
        else { const int e = L - 1024; if (e >= 128) return false; const int tile = e >> 3; kq = e & 7; u.pm = 32 + (tile >> 3); u.pn = 4 + (tile & 7); u.z = 1 + kq; u.nt = 4; }
        u.aoff = offA + (size_t)u.pm * (256 * 2048 * 2) + (size_t)kq * 512; u.boff = offB + (size_t)u.pn * (256 * 2048 * 2) + (size_t)kq * 512; return true; }
};
struct SchedF1 {
    int G, c; size_t offCS, offFE, offFO;
    __device__ __forceinline__ bool next(int i, Unit& u) const { const int L = i * G + c; if (L >= 136) return false; u.pm = 0; u.nt = 4;
        if (L < 72) { const int g = L / 18, r = L % 18, b = r / 9; u.pn = r % 9; u.z = g | (b << 2); u.aoff = offCS; u.boff = offFE + ((size_t)(b * 2304 + u.pn * 256) * 1024 + (size_t)g * 256) * 2; }
        else { const int e = L - 72, g = e >> 4, r = e & 15, b = r >> 3; u.pn = r & 7; u.z = g | (b << 2) | 8; u.aoff = offCS + (size_t)(256 * 256 * 2); u.boff = offFO + ((size_t)(b * 2048 + u.pn * 256) * 1024 + (size_t)g * 256) * 2; }
        return true; }
};
struct SchedF2 {
    int G, c; size_t offD, offT;
    __device__ __forceinline__ bool next(int i, Unit& u) const { const int L = i * G + c; if (L >= 256) return false;
        const int idx = L >> 3, p = idx & 3, bg = idx >> 2, koff = (p >> 1) * FKC + (p & 1) * 1024; u.pm = L & 7; u.pn = 0; u.z = (bg << 2) | p; u.nt = p == 1 ? 18 : 16;
        u.aoff = offD + ((size_t)u.pm * 256 * FKP + (size_t)koff) * 2; u.boff = offT + ((size_t)bg * 256 * FKP + (size_t)koff) * 2; return true; }
};
struct SchedMerged {
    Map2D mp; int G, c; size_t offA0, offB0, offA1, offB1;
    __device__ __forceinline__ bool next(int i, Unit& u) const { const int L = (i >> 1) * G + c; if (L >= mp.nwg) return false; mp.map(L, u.pm, u.pn); u.z = i & 1; u.nt = 16;
        u.aoff = (u.z ? offA1 : offA0) + (size_t)u.pm * (256 * 1024 * 2); u.boff = (u.z ? offB1 : offB0) + (size_t)u.pn * (256 * 1024 * 2); return true; }
};

constexpr float QSCALE = 0.125f * 1.4426950408889634f;
struct EpiG1 {
    static constexpr bool PERM = true;
    unsigned char* ws; const float *ropec, *ropes;
    __device__ __forceinline__ bool operator()(f32x4 (&acc)[2][2][4][2], const Unit& u_, int wr, int wc, int fr, int fq) const {
        Unit u; u.pm = u_.pm; u.pn = u_.pn; u.z = u_.z; asm volatile("" : "+s"(u.pm), "+s"(u.pn), "+s"(u.z));
        const int type = u.pn >> 2;
        const bool ctx = u.pm >= 32;
        if (type <= 1 && !ctx) {
            bf16_t* O = (bf16_t*)(ws + WS_Q + (size_t)type * (WS_K - WS_Q)); const float sc = type == 0 ? QSCALE : 1.f;
            const int cl = (u.pn & 3) * 256 + wc * 32 + 8 * fq;
#pragma unroll
            for (int ai = 0; ai < 2; ++ai)
#pragma unroll
                for (int m = 0; m < 4; ++m) {
                    const int tok = u.pm * BM + ai * HALF + wr * 64 + m * 16 + fr, b = tok >> 12, l = tok & 4095;
                    const int pos = (wc & 1) ? (l & 63) : (l >> 6);
                    const float* cp = ropec + pos * 16 + 8 * (fq & 1); const float* sp = ropes + pos * 16 + 8 * (fq & 1);
                    const f32x4 c0 = *(const f32x4*)cp, c1 = *(const f32x4*)(cp + 4); f32x4 s0 = *(const f32x4*)sp, s1 = *(const f32x4*)(sp + 4);
                    if (fq < 2) { s0 = -s0; s1 = -s1; }
                    const size_t orow = type == 0 ? (size_t)tok : (size_t)(b * 4352 + l);
                    bf16_t* rowp = O + orow * 1024 + cl;
#pragma unroll
                    for (int bj = 0; bj < 2; ++bj) { const f32x4 v0 = acc[ai][bj][m][0], v1 = acc[ai][bj][m][1]; f32x4 p0, p1;
#pragma unroll
                        for (int j = 0; j < 4; ++j) {
                            const auto r0 = __builtin_amdgcn_permlane32_swap(__float_as_uint(v0[j]), __float_as_uint(v0[j]), false, false); p0[j] = __uint_as_float(fq < 2 ? r0[1] : r0[0]);
                            const auto r1 = __builtin_amdgcn_permlane32_swap(__float_as_uint(v1[j]), __float_as_uint(v1[j]), false, false); p1[j] = __uint_as_float(fq < 2 ? r1[1] : r1[0]); }
                        const f32x4 o0 = (v0 * c0 + p0 * s0) * sc, o1 = (v1 * c1 + p1 * s1) * sc;
                        *(u32x4*)(rowp + bj * HALF) = pack8(o0, o1); }
                }
        } else if (ctx) {
            float* P = (float*)(ws + WS_PART) + (size_t)(u.z - 1) * (512 * 2048) + (u.pn - 4) * 256 + wc * 32 + 8 * fq;
#pragma unroll
            for (int ai = 0; ai < 2; ++ai)
#pragma unroll
                for (int m = 0; m < 4; ++m) { float* rowp = P + (size_t)((u.pm - 32) * BM + ai * HALF + wr * 64 + m * 16 + fr) * 2048;
#pragma unroll
                    for (int bj = 0; bj < 2; ++bj) { *(f32x4*)(rowp + bj * HALF) = acc[ai][bj][m][0]; *(f32x4*)(rowp + bj * HALF + 4) = acc[ai][bj][m][1]; } }
        } else if (type <= 3) {
            bf16_t* O = (bf16_t*)(ws + WS_K + (size_t)(type - 1) * (WS_V - WS_K));
            const int cl = (u.pn & 3) * 256 + wc * 32 + 8 * fq;
#pragma unroll
            for (int ai = 0; ai < 2; ++ai)
#pragma unroll
                for (int m = 0; m < 4; ++m) {
                    const int r = u.pm * BM + ai * HALF + wr * 64 + m * 16 + fr; size_t orow;
                    if (type == 3) orow = (size_t)r;
                    else orow = (size_t)((r >> 12) * 4352 + (r & 4095));
                    bf16_t* rowp = O + orow * 1024 + cl;
#pragma unroll
                    for (int bj = 0; bj < 2; ++bj) *(u32x4*)(rowp + bj * HALF) = pack8(acc[ai][bj][m][0], acc[ai][bj][m][1]);
                }
        } else {
            bf16_t* O = (bf16_t*)(ws + WS_SGA + (size_t)((type - 4) >> 1) * (WS_SGF - WS_SGA));
            const int cl = (u.pn & 7) * 256 + wc * 32 + 8 * fq;
#pragma unroll
            for (int ai = 0; ai < 2; ++ai)
#pragma unroll
                for (int m = 0; m < 4; ++m) {
                    const int r = u.pm * BM + ai * HALF + wr * 64 + m * 16 + fr; bf16_t* rowp = O + (size_t)r * 2048 + cl;
#pragma unroll
                    for (int bj = 0; bj < 2; ++bj) { f32x4 v0 = acc[ai][bj][m][0], v1 = acc[ai][bj][m][1];
#pragma unroll
                        for (int j = 0; j < 4; ++j) { v0[j] = __builtin_amdgcn_rcpf(1.f + __expf(-v0[j])); v1[j] = __builtin_amdgcn_rcpf(1.f + __expf(-v1[j])); }
                        st16_nt(rowp + bj * HALF, pack8(v0, v1)); }
                }
        }
        return false;
    }
};
struct EpiF1 {
    static constexpr bool PERM = true;
    bf16_t* TT;
    __device__ __forceinline__ bool operator()(f32x4 (&acc)[2][2][4][2], const Unit& u_, int wr, int wc, int fr, int fq) const {
        Unit u; u.pm = u_.pm; u.pn = u_.pn; u.z = u_.z; asm volatile("" : "+s"(u.pm), "+s"(u.pn), "+s"(u.z));
        const int g = u.z & 3, b = (u.z >> 2) & 1, cs = u.z >> 3;
#pragma unroll
        for (int ai = 0; ai < 2; ++ai)
#pragma unroll
            for (int m = 0; m < 4; ++m) { const int n = ai * HALF + wr * 64 + m * 16 + fr;
#pragma unroll
                for (int bj = 0; bj < 2; ++bj) { const int k0 = u.pn * BM + bj * HALF + wc * 32 + 8 * fq;
                    if (cs || k0 < FKC) *(u32x4*)(TT + ((size_t)((b * 4 + g) * 256 + n)) * FKP + cs * FKC + k0) = pack8(acc[ai][bj][m][0], acc[ai][bj][m][1]); } }
        return false;
    }
};
struct EpiF2 {
    static constexpr bool PERM = true;
    bf16_t* Y0;
    __device__ __forceinline__ bool operator()(f32x4 (&acc)[2][2][4][2], const Unit& u_, int wr, int wc, int fr, int fq) const {
        Unit u; u.pm = u_.pm; u.pn = u_.pn; u.z = u_.z; asm volatile("" : "+s"(u.pm), "+s"(u.pn), "+s"(u.z));
        const int p = u.z & 3, bg = u.z >> 2, b = bg >> 2, g = bg & 3; bf16_t* Y = Y0 + (size_t)p * (4096 * 1024);
#pragma unroll
        for (int ai = 0; ai < 2; ++ai)
#pragma unroll
            for (int m = 0; m < 4; ++m) { const int lp = u.pm * BM + ai * HALF + wr * 64 + m * 16 + fr; bf16_t* rowp = Y + ((size_t)(b * 2048 + lp)) * 1024 + g * 256 + wc * 32 + 8 * fq;
#pragma unroll
                for (int bj = 0; bj < 2; ++bj) *(u32x4*)(rowp + bj * HALF) = pack8(acc[ai][bj][m][0], acc[ai][bj][m][1]); }
        return false;
    }
};
struct EpiMerged {
    static constexpr bool PERM = true;
    const bf16_t *SGA, *SGF; bf16_t* Mb;
    __device__ __forceinline__ bool operator()(f32x4 (&acc)[2][2][4][2], const Unit& u_, int wr, int wc, int fr, int fq) const {
        Unit u; u.pm = u_.pm; u.pn = u_.pn; u.z = u_.z; asm volatile("" : "+s"(u.pm), "+s"(u.pn), "+s"(u.z));
        const int cl = u.pn * BM + wc * 32 + 8 * fq;
#pragma unroll
        for (int ai = 0; ai < 2; ++ai)
#pragma unroll
            for (int mp = 0; mp < 2; ++mp) {
                u32x4 gf[2][2], ga[2][2];
#pragma unroll
                for (int mm = 0; mm < 2; ++mm) { const size_t off = (size_t)(u.pm * BM + ai * HALF + wr * 64 + (2 * mp + mm) * 16 + fr) * 2048 + cl;
#pragma unroll
                    for (int bj = 0; bj < 2; ++bj) { gf[mm][bj] = __builtin_nontemporal_load((const u32x4*)(SGF + off + bj * HALF)); if (u.z == 0) ga[mm][bj] = __builtin_nontemporal_load((const u32x4*)(SGA + off + bj * HALF)); } }
                asm volatile("" ::: "memory");
#pragma unroll
                for (int mm = 0; mm < 2; ++mm) { const int m = 2 * mp + mm; const size_t off = (size_t)(u.pm * BM + ai * HALF + wr * 64 + m * 16 + fr) * 2048 + cl;
#pragma unroll
                    for (int bj = 0; bj < 2; ++bj) { f32x4 f0, f1; unpack8(gf[mm][bj], f0, f1);
                        if (u.z == 0) { f32x4 a0, a1; unpack8(ga[mm][bj], a0, a1);
#pragma unroll
                            for (int j = 0; j < 4; ++j) { acc[ai][bj][m][0][j] *= a0[j] * __builtin_amdgcn_rcpf(f0[j]); acc[ai][bj][m][1][j] *= a1[j] * __builtin_amdgcn_rcpf(f1[j]); }
                        } else *(u32x4*)(Mb + off + bj * HALF) = pack8(acc[ai][bj][m][0] * f0, acc[ai][bj][m][1] * f1); } }
                asm volatile("" ::: "memory"); }
        return u.z == 0;
    }
};
struct EpiRes {
    static constexpr bool PERM = false;
    const float* base; float* out; const float* gate;
    __device__ __forceinline__ bool operator()(f32x4 (&acc)[2][2][4][2], const Unit& u_, int wr, int wc, int fr, int fq) const {
        Unit u; u.pm = u_.pm; u.pn = u_.pn; u.z = u_.z; asm volatile("" : "+s"(u.pm), "+s"(u.pn), "+s"(u.z));
        const int b = u.pm >> 4, col0 = u.pn * BM + wc * 32 + 4 * fq; f32x4 gv[2][2];
#pragma unroll
        for (int bj = 0; bj < 2; ++bj)
#pragma unroll
            for (int n = 0; n < 2; ++n) gv[bj][n] = *(const f32x4*)(gate + (size_t)b * 12288 + col0 + bj * HALF + n * 16);
#pragma unroll
        for (int ai = 0; ai < 2; ++ai)
#pragma unroll
            for (int m = 0; m < 4; ++m) { const size_t off = (size_t)(u.pm * BM + ai * HALF + wr * 64 + m * 16 + fr) * 2048 + col0;
#pragma unroll
                for (int bj = 0; bj < 2; ++bj)
#pragma unroll
                    for (int n = 0; n < 2; ++n) *(f32x4*)(out + off + bj * HALF + n * 16) = *(const f32x4*)(base + off + bj * HALF + n * 16) + gv[bj][n] * acc[ai][bj][m][n]; }
        return false;
    }
};
struct EpiRelu2 {
    static constexpr bool PERM = true;
    bf16_t* Z;
    __device__ __forceinline__ bool operator()(f32x4 (&acc)[2][2][4][2], const Unit& u_, int wr, int wc, int fr, int fq) const {
        Unit u; u.pm = u_.pm; u.pn = u_.pn; u.z = u_.z; asm volatile("" : "+s"(u.pm), "+s"(u.pn), "+s"(u.z));
        const int cl = u.pn * BM + wc * 32 + 8 * fq;
#pragma unroll
        for (int ai = 0; ai < 2; ++ai)
#pragma unroll
            for (int m = 0; m < 4; ++m) { bf16_t* rowp = Z + (size_t)(u.pm * BM + ai * HALF + wr * 64 + m * 16 + fr) * 8192 + cl;
#pragma unroll
                for (int bj = 0; bj < 2; ++bj) { f32x4 v0 = acc[ai][bj][m][0], v1 = acc[ai][bj][m][1];
#pragma unroll
                    for (int j = 0; j < 4; ++j) { const float a = fmaxf(v0[j], 0.f), c = fmaxf(v1[j], 0.f); v0[j] = a * a; v1[j] = c * c; }
                    *(u32x4*)(rowp + bj * HALF) = pack8(v0, v1); } }
        return false;
    }
};
template <class Epi, class Sched, bool ALIGN_EPI = false, bool SP2 = false>
__device__ __forceinline__ void gemm_phase(PG8_LAS unsigned char* lds, const Gemm g, const Sched& S, const Epi& E) {
    const int tid = threadIdx.x, wid = __builtin_amdgcn_readfirstlane(tid >> 6), lane = tid & 63, wr = wid >> 2, wc = wid & 3, fr = lane & 15, fq = lane >> 4;
    unsigned voffA[2], voffB[2];
#pragma unroll
    for (int i = 0; i < 2; ++i) { int R, C; stage_rc(tid * 16 + i * 8192, R, C); const int Rb = Epi::PERM ? ((R & ~31) + perm32(R & 31)) : R;
        voffA[i] = (unsigned)(R * g.lda + C) * 2u; voffB[i] = (unsigned)(Rb * g.ldb + C) * 2u; }
    const size_t kstep = (size_t)(BK * 2);
    const size_t hstepA = (size_t)HALF * g.lda * 2, hstepB = (size_t)HALF * g.ldb * 2;
    const unsigned ldsw = (unsigned)wid * 1024u;
    const int aoff = lds_byte(wr * 64 + fr, fq * 8), boff = lds_byte(wc * 32 + fr, fq * 8);
#define PG8_SA(b, h) (((b) * 2 + (h)) * HTB)
#define PG8_SB(b, h) ((4 + (b) * 2 + (h)) * HTB)
#define PG8_STAGE(bufoff, gbase, voff) do { _Pragma("unroll") for (int _i = 0; _i < 2; ++_i) \
        __builtin_amdgcn_global_load_lds((const unsigned*)((const char*)(gbase) + (voff)[_i]), (PG8_LAS unsigned*)(lds + (bufoff) + ldsw + _i * 8192), 16, 0, 0); } while (0)
#define PG8_LDA(dst, b, h) do { _Pragma("unroll") for (int m = 0; m < 4; ++m) _Pragma("unroll") for (int k = 0; k < 2; ++k) dst[m][k] = *(const PG8_LAS bf16x8*)(lds + PG8_SA(b, h) + aoff + m * 2048 + k * 1024); } while (0)
#define PG8_LDB(dst, b, h) do { _Pragma("unroll") for (int n = 0; n < 2; ++n) _Pragma("unroll") for (int k = 0; k < 2; ++k) dst[n][k] = *(const PG8_LAS bf16x8*)(lds + PG8_SB(b, h) + boff + n * 2048 + k * 1024); } while (0)
#define PG8_MMA(ai, bj, At, Bt) do { __builtin_amdgcn_s_setprio(1); _Pragma("unroll") for (int m = 0; m < 4; ++m) _Pragma("unroll") for (int n = 0; n < 2; ++n) _Pragma("unroll") for (int k = 0; k < 2; ++k) \
        acc[ai][bj][m][n] = __builtin_amdgcn_mfma_f32_16x16x32_bf16(Bt[n][k], At[m][k], acc[ai][bj][m][n], 0, 0, 0); __builtin_amdgcn_s_setprio(0); } while (0)
#define PG8_WAIT_V(n) asm volatile("s_waitcnt vmcnt(" #n ")" ::: "memory")
#define PG8_WAIT_L(n) asm volatile("s_waitcnt lgkmcnt(" #n ")" ::: "memory")
#define PG8_BAR __builtin_amdgcn_s_barrier()
#define PG8_SCHED __builtin_amdgcn_sched_barrier(0)
    Unit cur, nxt; int ui = 0;
    if (!S.next(0, cur)) return;
    f32x4 acc[2][2][4][2];
#pragma unroll
    for (int a = 0; a < 2; ++a)
#pragma unroll
        for (int b = 0; b < 2; ++b)
#pragma unroll
            for (int m = 0; m < 4; ++m)
#pragma unroll
                for (int n = 0; n < 2; ++n) acc[a][b][m][n] = (f32x4){0.f, 0.f, 0.f, 0.f};
    bf16x8 At[4][2], B0[2][2], B1[2][2];
    const char* cA = (const char*)g.base + cur.aoff; const char* cB = (const char*)g.base + cur.boff;

    if constexpr (SP2) {
        PG8_STAGE(PG8_SB(0, 0), cB, voffB); PG8_STAGE(PG8_SB(0, 1), cB + hstepB, voffB); PG8_STAGE(PG8_SA(0, 0), cA, voffA); PG8_STAGE(PG8_SA(0, 1), cA + hstepA, voffA);
        if (wr == 1) PG8_BAR;
        PG8_WAIT_V(2); PG8_BAR;
        PG8_STAGE(PG8_SB(1, 0), cB + kstep, voffB); PG8_STAGE(PG8_SA(1, 0), cA + kstep, voffA); PG8_STAGE(PG8_SB(1, 1), cB + hstepB + kstep, voffB);
        PG8_WAIT_V(6); PG8_BAR;
    } else {
        PG8_STAGE(PG8_SB(0, 0), cB, voffB); PG8_STAGE(PG8_SA(0, 0), cA, voffA); PG8_STAGE(PG8_SB(0, 1), cB + hstepB, voffB); PG8_STAGE(PG8_SA(0, 1), cA + hstepA, voffA);
        if (wr == 1) PG8_BAR;
        PG8_WAIT_V(4); PG8_BAR;
        PG8_STAGE(PG8_SB(1, 0), cB + kstep, voffB); PG8_STAGE(PG8_SA(1, 0), cA + kstep, voffA); PG8_STAGE(PG8_SB(1, 1), cB + hstepB + kstep, voffB);
        PG8_WAIT_V(6); PG8_BAR;
    }
    for (;;) {
        const bool has_next = S.next(ui + 1, nxt);
        const char* nA = has_next ? (const char*)g.base + nxt.aoff : cA; const char* nB = has_next ? (const char*)g.base + nxt.boff : cB;
        int nt = cur.nt; asm volatile("" : "+s"(nt));
        for (int t = 0; t < nt; t += 2) {
            const bool last = (t == nt - 2);
            const char* a1 = cA + (size_t)(t + 1) * kstep;
            const char* a2 = last ? nA : cA + (size_t)(t + 2) * kstep; const char* b2 = last ? nB : cB + (size_t)(t + 2) * kstep;
            const char* a3 = a2 + kstep; const char* b3 = b2 + kstep;

            if constexpr (SP2) {
            PG8_LDB(B0, 0, 0); PG8_LDB(B1, 0, 1); PG8_SCHED; PG8_LDA(At, 0, 0); PG8_STAGE(PG8_SA(1, 1), a1 + hstepA, voffA);
            PG8_WAIT_V(8); PG8_WAIT_L(0); PG8_BAR; PG8_MMA(0, 0, At, B0); PG8_MMA(0, 1, At, B1); PG8_BAR; PG8_SCHED;
            PG8_LDA(At, 0, 1); PG8_STAGE(PG8_SB(0, 0), b2, voffB); PG8_STAGE(PG8_SB(0, 1), b2 + hstepB, voffB); PG8_STAGE(PG8_SA(0, 0), a2, voffA);
            PG8_WAIT_V(8); PG8_WAIT_L(0); PG8_BAR; PG8_MMA(1, 0, At, B0); PG8_MMA(1, 1, At, B1); PG8_BAR; PG8_SCHED;
            PG8_LDB(B0, 1, 0); PG8_LDB(B1, 1, 1); PG8_SCHED; PG8_LDA(At, 1, 0); PG8_STAGE(PG8_SA(0, 1), a2 + hstepA, voffA);
            PG8_WAIT_V(8); PG8_WAIT_L(0); PG8_BAR; PG8_MMA(0, 0, At, B0); PG8_MMA(0, 1, At, B1); PG8_BAR; PG8_SCHED;
            PG8_LDA(At, 1, 1); PG8_STAGE(PG8_SB(1, 0), b3, voffB); PG8_STAGE(PG8_SB(1, 1), b3 + hstepB, voffB); PG8_STAGE(PG8_SA(1, 0), a3, voffA);
            PG8_WAIT_V(8); PG8_WAIT_L(0); PG8_BAR; PG8_MMA(1, 0, At, B0); PG8_MMA(1, 1, At, B1); PG8_BAR; PG8_SCHED;
            } else {
            PG8_LDB(B0, 0, 0); PG8_SCHED; PG8_LDA(At, 0, 0); PG8_STAGE(PG8_SA(1, 1), a1 + hstepA, voffA);
            PG8_WAIT_L(8); PG8_BAR; PG8_WAIT_L(0); PG8_MMA(0, 0, At, B0); PG8_BAR; PG8_SCHED;
            PG8_LDB(B1, 0, 1); PG8_STAGE(PG8_SB(0, 0), b2, voffB);
            PG8_BAR; PG8_WAIT_L(0); PG8_MMA(0, 1, At, B1); PG8_BAR;
            PG8_LDA(At, 0, 1); PG8_STAGE(PG8_SA(0, 0), a2, voffA);
            PG8_BAR; PG8_WAIT_L(0); PG8_MMA(1, 0, At, B0); PG8_BAR; PG8_SCHED;
            PG8_STAGE(PG8_SB(0, 1), b2 + hstepB, voffB);
            PG8_WAIT_V(6); PG8_BAR; PG8_MMA(1, 1, At, B1); PG8_BAR;
            PG8_LDB(B0, 1, 0); PG8_SCHED; PG8_LDA(At, 1, 0); PG8_STAGE(PG8_SA(0, 1), a2 + hstepA, voffA);
            PG8_WAIT_L(8); PG8_BAR; PG8_WAIT_L(0); PG8_MMA(0, 0, At, B0); PG8_BAR; PG8_SCHED;
            PG8_LDB(B1, 1, 1); PG8_STAGE(PG8_SB(1, 0), b3, voffB);
            PG8_BAR; PG8_WAIT_L(0); PG8_MMA(0, 1, At, B1); PG8_BAR;
            PG8_LDA(At, 1, 1); PG8_STAGE(PG8_SA(1, 0), a3, voffA);
            PG8_BAR; PG8_WAIT_L(0); PG8_MMA(1, 0, At, B0); PG8_BAR; PG8_SCHED;
            PG8_STAGE(PG8_SB(1, 1), b3 + hstepB, voffB);
            PG8_WAIT_V(6); PG8_BAR; PG8_MMA(1, 1, At, B1); PG8_BAR;
            }
        }
        if constexpr (ALIGN_EPI) { if (wr == 0) PG8_BAR; }
        const bool keep = E(acc, cur, wr, wc, fr, fq);
        if (!has_next) break;
        if (!keep)
#pragma unroll
        for (int a = 0; a < 2; ++a)
#pragma unroll
            for (int b = 0; b < 2; ++b)
#pragma unroll
                for (int m = 0; m < 4; ++m)
#pragma unroll
                    for (int n = 0; n < 2; ++n) acc[a][b][m][n] = (f32x4){0.f, 0.f, 0.f, 0.f};
        cur = nxt; cA = nA; cB = nB; ++ui;
        if constexpr (ALIGN_EPI) { if (wr == 1) PG8_BAR; }
    }
    PG8_WAIT_V(0);
    if constexpr (!ALIGN_EPI) { if (wr == 0) PG8_BAR; }
    PG8_BAR;
#undef PG8_SA
#undef PG8_SB
#undef PG8_STAGE
#undef PG8_LDA
#undef PG8_LDB
#undef PG8_MMA
#undef PG8_WAIT_V
#undef PG8_WAIT_L
#undef PG8_BAR
#undef PG8_SCHED
}
}
#include <hip/hip_bf16.h>
#include <cmath>
namespace attn_body {
using bf16=__hip_bfloat16;
using bf16x8=__attribute__((ext_vector_type(8)))short;
using s16x4=__attribute__((ext_vector_type(4)))short;
using f32x16=__attribute__((ext_vector_type(16)))float;
using u32x4=__attribute__((ext_vector_type(4)))unsigned;
constexpr int BATCH=2,NHEAD=16,SEQ=4096,LK=4352,D=64,DM=NHEAD*D;
constexpr int NW=8,QBLK=32,QB=QBLK*NW,KVBLK=64,NQB=SEQ/QB;
constexpr int ATTN_PITCH=DM, ATTN_UNIT_ROWS=QB;
__device__ __forceinline__ int crow(int r,int hi){return (r&3)+8*(r>>2)+4*hi;}
#define SBAR() __builtin_amdgcn_sched_barrier(0)
constexpr int NSLOT=3, SLOTB=8192;
constexpr int LDS_K=0, LDS_V=NSLOT*SLOTB, LDS_WS=LDS_V+NSLOT*2*SLOTB, LDS_OST=LDS_WS+NW*64*4, LDS_BYTES=LDS_OST+NW*4096;
constexpr float C2=0.125f*1.4426950408889634f;
__device__ __forceinline__ void glds16(const void*gsrc,unsigned lds_dst){unsigned keep;
  asm volatile("s_mov_b32 %0, m0\n\ts_mov_b32 m0, %2\n\ts_nop 0\n\tglobal_load_lds_dwordx4 %1, off\n\ts_mov_b32 m0, %0":"=&s"(keep):"v"(gsrc),"s"(lds_dst):"memory");}
__device__ __forceinline__ float max3f(float a,float b,float c){float r;asm("v_max3_f32 %0, %1, %2, %3":"=v"(r):"v"(a),"v"(b),"v"(c));return r;}
__device__ __forceinline__ float max2f(float a,float b){float r;asm("v_max_f32_e32 %0, %1, %2":"=v"(r):"v"(a),"v"(b));return r;}
__device__ __forceinline__ float fadd_s(float a,float b){float r;asm("v_add_f32_e32 %0, %1, %2":"=v"(r):"v"(a),"v"(b));return r;}
__device__ __forceinline__ float fsub_s(float a,float b){float r;asm("v_sub_f32_e32 %0, %1, %2":"=v"(r):"v"(a),"v"(b));return r;}
typedef float f32x2_t __attribute__((ext_vector_type(2))); typedef __bf16 bf16x2_t __attribute__((ext_vector_type(2)));
__device__ __forceinline__ unsigned cvtpk_s(float lo,float hi){f32x2_t v={lo,hi};bf16x2_t b=__builtin_convertvector(v,bf16x2_t);return __builtin_bit_cast(unsigned,b);}
#define WAIT_BAR(N) asm volatile("s_waitcnt vmcnt(" #N ") lgkmcnt(0)\n\ts_barrier":::"memory")

__device__ __forceinline__ void qkt(f32x16&p0,f32x16&p1,const char*Kslot,const bf16x8*qr,const f32x16&negm,int r32,int hi){
  const char*kb=Kslot+hi*1024+r32*16;
  #pragma unroll
  for(int d0=0;d0<4;++d0){
    const bf16x8 b0=*reinterpret_cast<const bf16x8*>(kb+d0*2048);
    const bf16x8 b1=*reinterpret_cast<const bf16x8*>(kb+d0*2048+512);
    if(d0==0){p0=__builtin_amdgcn_mfma_f32_32x32x16_bf16(b0,qr[0],negm,0,0,0);p1=__builtin_amdgcn_mfma_f32_32x32x16_bf16(b1,qr[0],negm,0,0,0);}
    else{p0=__builtin_amdgcn_mfma_f32_32x32x16_bf16(b0,qr[d0],p0,0,0,0);p1=__builtin_amdgcn_mfma_f32_32x32x16_bf16(b1,qr[d0],p1,0,0,0);}}
}
typedef __attribute__((address_space(3))) const char* lds_cptr;
typedef short v4i16_t __attribute__((ext_vector_type(4)));
__device__ __forceinline__ void kload8(bf16x8*kf,lds_cptr kp){
  kf[0]=*(const __attribute__((address_space(3))) bf16x8*)(kp);      kf[1]=*(const __attribute__((address_space(3))) bf16x8*)(kp+512);
  kf[2]=*(const __attribute__((address_space(3))) bf16x8*)(kp+2048); kf[3]=*(const __attribute__((address_space(3))) bf16x8*)(kp+2560);
  kf[4]=*(const __attribute__((address_space(3))) bf16x8*)(kp+4096); kf[5]=*(const __attribute__((address_space(3))) bf16x8*)(kp+4608);
  kf[6]=*(const __attribute__((address_space(3))) bf16x8*)(kp+6144); kf[7]=*(const __attribute__((address_space(3))) bf16x8*)(kp+6656);
}
__device__ __forceinline__ void kload2(bf16x8*kf,lds_cptr kp,int j){ kf[2*j]=*(const __attribute__((address_space(3))) bf16x8*)(kp+j*2048); kf[2*j+1]=*(const __attribute__((address_space(3))) bf16x8*)(kp+j*2048+512); }
__device__ __forceinline__ s16x4 vtr(lds_cptr p){ return __builtin_bit_cast(s16x4,__builtin_amdgcn_ds_read_tr16_b64_v4i16((__attribute__((address_space(3))) v4i16_t*)p)); }
__device__ __forceinline__ float rowmax(const f32x16&p0,const f32x16&p1){
  float a=max3f(p0[0],p0[1],p1[0]),b=max3f(p0[2],p0[3],p1[1]);a=max3f(a,p1[2],p1[3]);
  #pragma unroll
  for(int r=4;r<16;r+=4){a=max3f(a,p0[r],p0[r+1]);b=max3f(b,p0[r+2],p0[r+3]);a=max3f(a,p1[r],p1[r+1]);b=max3f(b,p1[r+2],p1[r+3]);}
  const float m=max2f(a,b);
  auto rr=__builtin_amdgcn_permlane32_swap(__float_as_uint(m),__float_as_uint(m),false,false);
  return max2f(__uint_as_float(rr[0]),__uint_as_float(rr[1]));
}
__device__ __forceinline__ void pv(f32x16*o,int vb,bf16x8 pa0,bf16x8 pa1,bf16x8 pa2,bf16x8 pa3){
  #pragma unroll
  for(int d0=0;d0<4;++d0){s16x4 lo[4],hi[4];
    #pragma unroll
    for(int ks=0;ks<4;++ks){
      asm volatile("ds_read_b64_tr_b16 %0,%1 offset:%c2":"=&v"(lo[ks]):"v"(vb),"i"(d0*4096+ks*1024):"memory");
      asm volatile("ds_read_b64_tr_b16 %0,%1 offset:%c2":"=&v"(hi[ks]):"v"(vb),"i"(d0*4096+ks*1024+512):"memory");}
    asm volatile("s_waitcnt lgkmcnt(0)":::"memory");SBAR();
    #define PK(k) (bf16x8){lo[k][0],lo[k][1],lo[k][2],lo[k][3],hi[k][0],hi[k][1],hi[k][2],hi[k][3]}
    o[d0]=__builtin_amdgcn_mfma_f32_32x32x16_bf16(pa0,PK(0),o[d0],0,0,0);
    o[d0]=__builtin_amdgcn_mfma_f32_32x32x16_bf16(pa1,PK(1),o[d0],0,0,0);
    o[d0]=__builtin_amdgcn_mfma_f32_32x32x16_bf16(pa2,PK(2),o[d0],0,0,0);
    o[d0]=__builtin_amdgcn_mfma_f32_32x32x16_bf16(pa3,PK(3),o[d0],0,0,0);
    #undef PK
  }
}

#ifndef ATTN_STORE16
#define ATTN_STORE16(p,v) (*(u32x4*)(p)=(v))
#endif
template<int THRL> __device__ __forceinline__ void attn_unit(const bf16*Qu,const bf16*__restrict__ Kh,const bf16*__restrict__ Vh,bf16*Ou,char*shm){
  const int tid=threadIdx.x,lane=tid&63,r32=lane&31,hi=lane>>5; const int wid=__builtin_amdgcn_readfirstlane(tid>>6);
  const bf16*Qw=Qu+(long)wid*QBLK*DM;
  const unsigned lds0=(unsigned)(uintptr_t)shm;
  float*wsf=(float*)(shm+LDS_WS)+wid*64;
  const bf16*ksrc=Kh+(long)lane*DM+wid*8;
  const bf16*vsrc=Vh+(long)(16*(wid&3)+(lane>>2))*DM+(wid>>2)*32+(lane&3)*8;
  const unsigned kdst=lds0+LDS_K+wid*1024, vdst=lds0+LDS_V+wid*1024;
  #define DMA_K(t,slot) glds16(ksrc+(long)(t)*KVBLK*DM,(unsigned)__builtin_amdgcn_readfirstlane(kdst+(slot)))
  #define DMA_V(t,slot) do{ glds16(vsrc+(long)(t)*KVBLK*DM,(unsigned)__builtin_amdgcn_readfirstlane(vdst+2*(slot))); glds16(vsrc+(long)(t)*KVBLK*DM+64,(unsigned)__builtin_amdgcn_readfirstlane(vdst+2*(slot)+8192)); }while(0)
  const int vb0=(int)(lds0+LDS_V)+((lane>>4)&1)*32+(lane&3)*8+(4*hi+((lane&15)>>2))*64;
  const char*Kbase=shm+LDS_K; bf16x8 kf[8];
  const lds_cptr shm3=(lds_cptr)shm; const lds_cptr kp0=shm3+LDS_K+hi*1024+r32*16; const lds_cptr vp0=shm3+LDS_V+((lane>>4)&1)*32+(lane&3)*8+(4*hi+((lane&15)>>2))*64;
  constexpr int NT=LK/KVBLK;
  DMA_K(0,0);DMA_V(0,0);DMA_K(1,SLOTB);
  bf16x8 qr[4];
  #pragma unroll
  for(int d0=0;d0<4;++d0)qr[d0]=*reinterpret_cast<const bf16x8*>(&Qw[(long)r32*DM+d0*16+hi*8]);
  float mhat=0.f,l_reg=0.f;f32x16 o[4];o[0]=f32x16{};o[1]=f32x16{};o[2]=f32x16{};o[3]=f32x16{};float nm=0.f;
  #define CMASK(P0,P1,t) do{}while(0)
  bool resc=false;
  #define START(P0,P1) do{ const float rm=rowmax(P0,P1); resc=false; \
    { const float dl=rm; mhat=fadd_s(mhat,dl); \
      _Pragma("unroll") for(int r=0;r<16;++r){P0[r]=fsub_s(P0[r],dl);P1[r]=fsub_s(P1[r],dl);} \
      nm=-mhat; } \
    _Pragma("unroll") for(int r=0;r<16;++r)P0[r]=__builtin_amdgcn_exp2f(P0[r]); }while(0)
  #define RESC() do{ if(resc){ asm volatile("s_waitcnt lgkmcnt(0)":::"memory"); \
      _Pragma("unroll") for(int d_=0;d_<4;++d_) _Pragma("unroll") for(int r=0;r<16;++r)o[d_][r]*=wsf[crow(r,hi)]; } }while(0)
  f32x16 pA0,pA1,pB0,pB1;
  int sl_prev=0,sl_cur=0,sl_next=SLOTB;
  #define ROT() do{sl_prev=sl_cur;sl_cur=sl_next;sl_next=(sl_next==(NSLOT-1)*SLOTB)?0:sl_next+SLOTB;}while(0)
  DMA_K(2,2*SLOTB);
  WAIT_BAR(4);
  { f32x16 T0_; _Pragma("unroll") for(int r=0;r<16;++r)T0_[r]=nm; qkt(pA0,pA1,Kbase,qr,T0_,r32,hi); }asm volatile("s_nop 15\n\ts_nop 7":"+v"(pA0),"+v"(pA1));CMASK(pA0,pA1,0);
  START(pA0,pA1);
  _Pragma("unroll") for(int r=0;r<16;++r)pA1[r]=__builtin_amdgcn_exp2f(pA1[r]);
  WAIT_BAR(0);
  DMA_K(3,0);DMA_V(1,SLOTB);
  ROT();
  kload8(kf,kp0+sl_cur);
  WAIT_BAR(3);
  s16x4 vlo[8],vhi[8]; u32x4 pw0,pw1,pw2,pw3;
  #define PKW(P,B) cvtpk_s(P[B],P[B+1])
  #define PAF(k) __builtin_bit_cast(bf16x8,pw##k)
  #define VFR(i) (bf16x8){vlo[i][0],vlo[i][1],vlo[i][2],vlo[i][3],vhi[i][0],vhi[i][1],vhi[i][2],vhi[i][3]}
  #define PIN(x) asm volatile("":"+v"(x))
  #define MX3(a,b,c) __builtin_fmaxf(__builtin_fmaxf((a),(b)),(c))
  #define GAPA(MF,A0,A1,A2,A3,W0,W1,PW) do{ MF; sacc+=A0; sacc+=A1; sacc+=A2; sacc+=A3; PIN(sacc); W0; W1; PIN(PW); SBAR(); }while(0)
  #define EX(v) __builtin_amdgcn_exp2f(v)
  #define GAPB(MF,X,B) do{ MF; X[B]=EX(X[B]); X[B+1]=EX(X[B+1]); PIN(X); SBAR(); }while(0)
  #define VRD(i,d0,ks) do{ vlo[i]=vtr(vp_+((d0)*4096+(ks)*1024)); vhi[i]=vtr(vp_+((d0)*4096+(ks)*1024+512)); }while(0)
  #define KRD(G,j) do{ if(G){ kload2(kf,kp0+sl_next,j); SBAR(); } }while(0)
  #define STEP(C0,C1,P0,P1,t,GK,GV,GL) do{ SBAR(); \
    const lds_cptr vp_=vp0+2*sl_prev; f32x16 T_; _Pragma("unroll") for(int r=0;r<16;++r)T_[r]=nm; \
    VRD(0,0,0); SBAR(); float sacc=(P0[0]+P0[1]); \
    GAPA(C0=__builtin_amdgcn_mfma_f32_32x32x16_bf16(kf[0],qr[0],T_,0,0,0), P0[2],P0[3],P0[4],P0[5],     pw0[0]=PKW(P0,0), pw0[1]=PKW(P0,2), pw0); \
    GAPA(C1=__builtin_amdgcn_mfma_f32_32x32x16_bf16(kf[1],qr[0],T_,0,0,0), P0[6],P0[7],P0[8],P0[9],     pw0[2]=PKW(P0,4), pw0[3]=PKW(P0,6), pw0); \
    VRD(1,1,0); SBAR(); GAPA(C0=__builtin_amdgcn_mfma_f32_32x32x16_bf16(kf[2],qr[1],C0,0,0,0),   P0[10],P0[11],P0[12],P0[13], pw1[0]=PKW(P0,8), pw1[1]=PKW(P0,10), pw1); \
    GAPA(C1=__builtin_amdgcn_mfma_f32_32x32x16_bf16(kf[3],qr[1],C1,0,0,0),   P0[14],P0[15],P1[0],P1[1],   pw1[2]=PKW(P0,12),pw1[3]=PKW(P0,14), pw1); \
    VRD(2,0,1); SBAR(); GAPA(C0=__builtin_amdgcn_mfma_f32_32x32x16_bf16(kf[4],qr[2],C0,0,0,0),   P1[2],P1[3],P1[4],P1[5],     pw2[0]=PKW(P1,0), pw2[1]=PKW(P1,2), pw2); \
    GAPA(C1=__builtin_amdgcn_mfma_f32_32x32x16_bf16(kf[5],qr[2],C1,0,0,0),   P1[6],P1[7],P1[8],P1[9],     pw2[2]=PKW(P1,4), pw2[3]=PKW(P1,6), pw2); \
    VRD(3,1,1); SBAR(); GAPA(C0=__builtin_amdgcn_mfma_f32_32x32x16_bf16(kf[6],qr[3],C0,0,0,0),   P1[10],P1[11],P1[12],P1[13], pw3[0]=PKW(P1,8), pw3[1]=PKW(P1,10), pw3); \
    GAPA(C1=__builtin_amdgcn_mfma_f32_32x32x16_bf16(kf[7],qr[3],C1,0,0,0),   P1[14],P1[15],0.f,0.f,       pw3[2]=PKW(P1,12),pw3[3]=PKW(P1,14), pw3); \
    l_reg+=sacc; \
    if(GK){DMA_K((t)+3,sl_cur);} if(GV){DMA_V((t)+1,sl_next);} \
    CMASK(C0,C1,t); \
    { float a=MX3(C0[0],C0[1],C1[0]),b=MX3(C0[2],C0[3],C1[1]); a=MX3(a,C1[2],C1[3]); \
      _Pragma("unroll") for(int r=4;r<16;r+=4){a=MX3(a,C0[r],C0[r+1]);b=MX3(b,C0[r+2],C0[r+3]);a=MX3(a,C1[r],C1[r+1]);b=MX3(b,C1[r+2],C1[r+3]);} \
      float rm=__builtin_fmaxf(a,b); { auto rr=__builtin_amdgcn_permlane32_swap(__float_as_uint(rm),__float_as_uint(rm),false,false); rm=__builtin_fmaxf(__uint_as_float(rr[0]),__uint_as_float(rr[1])); } \
      resc=false; \
      if(__builtin_expect(__any(rm>(float)THRL),0)){ const float dl=__builtin_fmaxf(rm,0.f); mhat+=dl; \
        _Pragma("unroll") for(int r=0;r<16;++r){C0[r]-=dl;C1[r]-=dl;} \
        nm=-mhat; \
        const float f=__builtin_amdgcn_exp2f(-dl); l_reg*=f; if(hi==0)wsf[r32]=f; resc=true; } } \
    SBAR(); \
      \
    VRD(4,0,2); SBAR(); GAPB(o[0]=__builtin_amdgcn_mfma_f32_32x32x16_bf16(PAF(0),VFR(0),o[0],0,0,0), C0,0); \
    VRD(5,1,2); SBAR(); GAPB(o[1]=__builtin_amdgcn_mfma_f32_32x32x16_bf16(PAF(0),VFR(1),o[1],0,0,0), C0,2); \
    VRD(6,0,3); SBAR(); GAPB(o[0]=__builtin_amdgcn_mfma_f32_32x32x16_bf16(PAF(1),VFR(2),o[0],0,0,0), C0,4); \
    VRD(7,1,3); SBAR(); GAPB(o[1]=__builtin_amdgcn_mfma_f32_32x32x16_bf16(PAF(1),VFR(3),o[1],0,0,0), C0,6); \
      \
    KRD(GL,0); GAPB(o[0]=__builtin_amdgcn_mfma_f32_32x32x16_bf16(PAF(2),VFR(4),o[0],0,0,0), C0,8);  VRD(0,2,0); SBAR(); \
    KRD(GL,1); GAPB(o[1]=__builtin_amdgcn_mfma_f32_32x32x16_bf16(PAF(2),VFR(5),o[1],0,0,0), C0,10); VRD(1,3,0); SBAR(); \
    KRD(GL,2); GAPB(o[0]=__builtin_amdgcn_mfma_f32_32x32x16_bf16(PAF(3),VFR(6),o[0],0,0,0), C0,12); VRD(2,2,1); SBAR(); \
    KRD(GL,3); GAPB(o[1]=__builtin_amdgcn_mfma_f32_32x32x16_bf16(PAF(3),VFR(7),o[1],0,0,0), C0,14); VRD(3,3,1); SBAR(); \
      \
    GAPB(o[2]=__builtin_amdgcn_mfma_f32_32x32x16_bf16(PAF(0),VFR(0),o[2],0,0,0), C1,0);  VRD(4,2,2); SBAR(); \
    GAPB(o[3]=__builtin_amdgcn_mfma_f32_32x32x16_bf16(PAF(0),VFR(1),o[3],0,0,0), C1,2);  VRD(5,3,2); SBAR(); \
    GAPB(o[2]=__builtin_amdgcn_mfma_f32_32x32x16_bf16(PAF(1),VFR(2),o[2],0,0,0), C1,4);  VRD(6,2,3); SBAR(); \
    GAPB(o[3]=__builtin_amdgcn_mfma_f32_32x32x16_bf16(PAF(1),VFR(3),o[3],0,0,0), C1,6);  VRD(7,3,3); SBAR(); \
      \
    GAPB(o[2]=__builtin_amdgcn_mfma_f32_32x32x16_bf16(PAF(2),VFR(4),o[2],0,0,0), C1,8); \
    GAPB(o[3]=__builtin_amdgcn_mfma_f32_32x32x16_bf16(PAF(2),VFR(5),o[3],0,0,0), C1,10); \
    GAPB(o[2]=__builtin_amdgcn_mfma_f32_32x32x16_bf16(PAF(3),VFR(6),o[2],0,0,0), C1,12); \
    GAPB(o[3]=__builtin_amdgcn_mfma_f32_32x32x16_bf16(PAF(3),VFR(7),o[3],0,0,0), C1,14); \
    }while(0)
  int t=1;
  #undef CMASK
  #define CMASK(P0,P1,t) do{}while(0)
  for(;t+5<NT;t+=2){
    STEP(pB0,pB1,pA0,pA1,t,true,true,true);     WAIT_BAR(3); RESC(); ROT();
    STEP(pA0,pA1,pB0,pB1,t+1,true,true,true);   WAIT_BAR(3); RESC(); ROT();
  }
  #undef CMASK
  #define CMASK(P0,P1,t) do{}while(0)
  #define ENDW(tt) do{ if((tt)+3<NT){WAIT_BAR(3);} else if((tt)+2<NT){WAIT_BAR(2);} else {WAIT_BAR(0);} }while(0)
  for(;t+1<NT;t+=2){
    STEP(pB0,pB1,pA0,pA1,t,(t+3<NT),(t+1<NT),(t+1<NT));       ENDW(t);   RESC(); ROT();
    STEP(pA0,pA1,pB0,pB1,t+1,(t+4<NT),(t+2<NT),(t+2<NT));     ENDW(t+1); RESC(); ROT();
  }
  STEP(pB0,pB1,pA0,pA1,NT-1,false,false,false); RESC();
  { float sacc=pB0[0]+pB0[1]; _Pragma("unroll") for(int r=2;r<16;++r)sacc+=pB0[r]; _Pragma("unroll") for(int r=0;r<16;++r)sacc+=pB1[r]; l_reg+=sacc;
    pw0=(u32x4){PKW(pB0,0),PKW(pB0,2),PKW(pB0,4),PKW(pB0,6)};pw1=(u32x4){PKW(pB0,8),PKW(pB0,10),PKW(pB0,12),PKW(pB0,14)};pw2=(u32x4){PKW(pB1,0),PKW(pB1,2),PKW(pB1,4),PKW(pB1,6)};pw3=(u32x4){PKW(pB1,8),PKW(pB1,10),PKW(pB1,12),PKW(pB1,14)};
    SBAR(); pv(o,vb0+2*sl_cur,PAF(0),PAF(1),PAF(2),PAF(3)); }
  #undef PKW
  #undef PAF
  #undef VFR
  #undef PIN
  #undef MX3
  #undef GAPA
  #undef GAPB
  #undef EX
  #undef VRD
  #undef KRD
  #undef STEP
  #undef ENDW
  {auto rr=__builtin_amdgcn_permlane32_swap(__float_as_uint(l_reg),__float_as_uint(l_reg),false,false);l_reg=__uint_as_float(rr[0])+__uint_as_float(rr[1]);}
  if(hi==0)wsf[32+r32]=l_reg;asm volatile("s_waitcnt lgkmcnt(0)":::"memory");
  float rli[16];
  #pragma unroll
  for(int r=0;r<16;++r)rli[r]=__builtin_amdgcn_rcpf(wsf[32+crow(r,hi)]);
  bf16*Ow=Ou+(long)wid*QBLK*DM;
  { bf16*stg=(bf16*)(shm+LDS_OST)+wid*2048;
    #pragma unroll
    for(int hv=0;hv<2;++hv){
      #pragma unroll
      for(int r=0;r<16;++r){const int orow=crow(r,hi);
        #pragma unroll
        for(int d0=0;d0<2;++d0)stg[orow*64+d0*32+r32]=__float2bfloat16(o[2*hv+d0][r]*rli[r]);}
      asm volatile("s_waitcnt lgkmcnt(0)":::"memory");
      #pragma unroll
      for(int i=0;i<4;++i){const int row=i*8+(lane>>3),ch=lane&7; const u32x4 v=*(const u32x4*)(stg+row*64+ch*8); ATTN_STORE16(Ow+(long)row*DM+hv*64+ch*8,v);}
      asm volatile("s_waitcnt lgkmcnt(0)":::"memory");
    } }
  asm volatile("s_waitcnt lgkmcnt(0)\n\ts_barrier":::"memory");
  #undef DMA_K
  #undef DMA_V
  #undef CMASK
  #undef START
  #undef RESC
  #undef ROT
}
constexpr int ATTN_LDS_BYTES=LDS_BYTES;
#undef SBAR
#undef WAIT_BAR
}
#define GAS __attribute__((address_space(1)))
#define LAS __attribute__((address_space(3)))
typedef unsigned short bf16;
typedef unsigned v4u __attribute__((ext_vector_type(4)));
typedef float f32x4 __attribute__((ext_vector_type(4)));
typedef short bf16x8 __attribute__((ext_vector_type(8)));
typedef GAS unsigned gu32;
typedef GAS unsigned long long gu64;
#define RLX_AGENT __ATOMIC_RELAXED, __HIP_MEMORY_SCOPE_AGENT
#define LDS_WAIT() asm volatile("s_waitcnt lgkmcnt(0)" ::: "memory")
#define VM_WAIT() asm volatile("s_waitcnt vmcnt(0)" ::: "memory")
__device__ __forceinline__ unsigned long long rt() { return __builtin_amdgcn_s_memrealtime(); }
__device__ __forceinline__ unsigned f2bf(float f) { unsigned u = __builtin_bit_cast(unsigned, f); return (u + 0x7fffu + ((u >> 16) & 1u)) >> 16; }
__device__ __forceinline__ unsigned pk2(float lo, float hi) { return f2bf(lo) | (f2bf(hi) << 16); }

#define XB_TMO      128
#define XB_XCNT(j)  (256  + 64 * (j))
#define XB_XSUB(j)  (1280 + 64 * (j))
#define XB_XGEN(j)  (2304 + 64 * (j))
#define XB_TOP      3328
#define XB_TOPGEN   3392
#define XCD_BAR_WORDS 3456
#define XB_SPIN_CAP (1u << 18)

__device__ __forceinline__ unsigned xb_ld(unsigned* p)              { return __hip_atomic_load(p, __ATOMIC_RELAXED, __HIP_MEMORY_SCOPE_AGENT); }
__device__ __forceinline__ unsigned xb_add(unsigned* p, unsigned v) { return __hip_atomic_fetch_add(p, v, __ATOMIC_RELAXED, __HIP_MEMORY_SCOPE_AGENT); }
__device__ __forceinline__ unsigned xb_xcc_id() { return (unsigned)__builtin_amdgcn_s_getreg((3 << 11) | 20) & 0xFu; }
#define XB_SPIN(cond, bar) do { unsigned _sp = 0; while (cond) { __builtin_amdgcn_s_sleep(1); \
    if ((++_sp & 255u) == 0u) { if (xb_ld(&(bar)[XB_TMO])) break; if (_sp > XB_SPIN_CAP) { atomicAdd(&(bar)[XB_TMO], 1u); break; } } } } while (0)

struct XcdBarrier {
    unsigned* bar; unsigned x;
    volatile LAS unsigned* st;
};

__device__ __forceinline__ XcdBarrier xcd_barrier_post(unsigned* bar, volatile LAS unsigned* st) {
    XcdBarrier b; b.bar = bar; b.x = xb_xcc_id(); b.st = st;
    if (threadIdx.x == 0) (void)xb_add(&bar[XB_XCNT(b.x)], 1u);
    return b;
}
__device__ __forceinline__ void xcd_barrier_complete(unsigned* bar, unsigned x, unsigned& nloc, unsigned& nx) {
    const unsigned G = gridDim.x * gridDim.y * gridDim.z;
    unsigned sum, cnt, mine, sp = 0u;
    for (;;) {
        sum = 0u; cnt = 0u; mine = 0u;
#pragma unroll
        for (unsigned j = 0; j < 16; ++j) { const unsigned c = xb_ld(&bar[XB_XCNT(j)]); sum += c; cnt += (c > 0u) ? 1u : 0u; mine = (j == x) ? c : mine; }
        if (sum == G) break;
        __builtin_amdgcn_s_sleep(1);
        if ((++sp & 255u) == 0u) { if (xb_ld(&bar[XB_TMO])) break; if (sp > XB_SPIN_CAP) { atomicAdd(&bar[XB_TMO], 1u); break; } }
    }
    nloc = mine > 0u ? mine : 1u; nx = cnt > 0u ? cnt : 1u;
}

__device__ __forceinline__ void xcd_barrier(const XcdBarrier& b) {
    asm volatile("s_waitcnt vmcnt(0)" ::: "memory");
    __syncthreads();
    if (threadIdx.x == 0) {
        unsigned* bar = b.bar;
        __builtin_amdgcn_s_waitcnt(0);
        unsigned nloc = b.st[0], nx = b.st[1];
        if (nloc == 0u) { xcd_barrier_complete(bar, b.x, nloc, nx); b.st[0] = nloc; b.st[1] = nx; }
        const unsigned old = xb_add(&bar[XB_XSUB(b.x)], 1u);
        const unsigned gen = old / nloc;
        if (old + 1u == (gen + 1u) * nloc) {
            __builtin_amdgcn_fence(__ATOMIC_RELEASE, "agent");
            asm volatile("s_waitcnt vmcnt(0)" ::: "memory");
            const unsigned og = xb_add(&bar[XB_TOP], 1u);
            const unsigned tg = og / nx;
            if (og + 1u == (tg + 1u) * nx) xb_add(&bar[XB_TOPGEN], 1u);
            else XB_SPIN(xb_ld(&bar[XB_TOPGEN]) == tg, bar);
            __builtin_amdgcn_fence(__ATOMIC_ACQUIRE, "agent");
            xb_add(&bar[XB_XGEN(b.x)], 1u);
            asm volatile("s_waitcnt vmcnt(0)" ::: "memory");
        } else {
            XB_SPIN(xb_ld(&bar[XB_XGEN(b.x)]) == gen, bar);
            __builtin_amdgcn_fence(__ATOMIC_ACQUIRE, "agent");
            asm volatile("s_waitcnt vmcnt(0)" ::: "memory");
        }
    }
    __syncthreads();
}
#ifndef PROBE_SEL
#define PROBE_SEL -1
#endif
__device__ __forceinline__ float wave_sum(float v) {
#pragma unroll
    for (int o = 1; o < 64; o <<= 1) v += __shfl_xor(v, o);
    return v;
}
__device__ __forceinline__ void p0_transpose_item(const float* W, int K, int N, bf16* WT, LAS float* scr, int item, int lane) {
    const int nblk = N / 32, kb = item / nblk, nb = item % nblk, k0 = 64 * kb, n0 = 32 * nb;
    float rg[32];
    const float* wp = W + (size_t)(k0 + (lane >> 5)) * N + n0 + (lane & 31);
#pragma unroll
    for (int i = 0; i < 32; ++i) rg[i] = __builtin_nontemporal_load(wp + (size_t)(2 * i) * N);
#pragma unroll
    for (int i = 0; i < 32; ++i) scr[(2 * i + (lane >> 5)) * 33 + (lane & 31)] = rg[i];
    LDS_WAIT(); asm volatile("" ::: "memory");
    const int c = lane & 7;
#pragma unroll
    for (int j = 0; j < 4; ++j) { const int n = (lane >> 3) + 8 * j; const LAS float* s = scr + (8 * c) * 33 + n;
        v4u o; o.x = pk2(s[0 * 33], s[1 * 33]); o.y = pk2(s[2 * 33], s[3 * 33]); o.z = pk2(s[4 * 33], s[5 * 33]); o.w = pk2(s[6 * 33], s[7 * 33]);
        *(GAS v4u*)(WT + (size_t)(n0 + n) * K + k0 + 8 * c) = o; }
    LDS_WAIT(); asm volatile("" ::: "memory");
}
__device__ __forceinline__ void row_load(const float* xrow, int lane, f32x4 (&v)[8]) {
    const GAS f32x4* xr = (const GAS f32x4*)xrow + lane;
#pragma unroll
    for (int j = 0; j < 8; ++j) v[j] = xr[64 * j];
}
__device__ __forceinline__ void row_load_nt(const float* xrow, int lane, f32x4 (&v)[8]) {
    const f32x4* xr = (const f32x4*)xrow + lane;
#pragma unroll
    for (int j = 0; j < 8; ++j) v[j] = __builtin_nontemporal_load(xr + 64 * j);
}
__device__ __forceinline__ float row_rstd(const f32x4 (&v)[8]) {
    float s = 0.f;
#pragma unroll
    for (int j = 0; j < 8; ++j) s += (v[j].x * v[j].x + v[j].y * v[j].y) + (v[j].z * v[j].z + v[j].w * v[j].w);
    return 1.f / sqrtf(wave_sum(s) * (1.f / DM_) + EPS_);
}
__device__ __forceinline__ void norm_mod_store(const f32x4 (&v)[8], const float* g, const float* sh, const float* sc, bf16* orow, int lane) {
    const float rstd = row_rstd(v);
    GAS unsigned long long* o8 = (GAS unsigned long long*)orow + lane;
#pragma unroll
    for (int j = 0; j < 8; ++j) { const f32x4 gg = ((const GAS f32x4*)g)[64 * j + lane], hh = ((const GAS f32x4*)sh)[64 * j + lane], cc = ((const GAS f32x4*)sc)[64 * j + lane];
        const f32x4 y = v[j] * rstd * gg * (cc + 1.0f) + hh;
        o8[64 * j] = (unsigned long long)pk2(y.x, y.y) | ((unsigned long long)pk2(y.z, y.w) << 32); }
}
#define ROW_PIPE(m0, step, M, LOAD, BODY) ROW_PIPE_N(8, m0, step, M, LOAD, BODY)
#define ROW_PIPE_N(NB, m0, step, M, LOAD, BODY) do { int m_ = (m0); f32x4 va_[NB], vb_[NB]; if (m_ < (M)) { LOAD(va_, m_); } \
    while (m_ < (M)) { const int m1_ = m_ + (step); if (m1_ < (M)) { LOAD(vb_, m1_); } BODY(va_, m_); if (m1_ >= (M)) break; \
        const int m2_ = m1_ + (step); if (m2_ < (M)) { LOAD(va_, m2_); } BODY(vb_, m1_); m_ = m2_; } } while (0)

template <int MODE> struct EpiResNorm {
    static constexpr bool PERM = false;
    const float* base; float* out; const float* gate; float* rowsq; const float* gvec; const float* mod_sc; const float* mod_sh; bf16* xn; XcdBarrier bar; float probe_delta;
    __device__ __forceinline__ bool operator()(pg8::f32x4 (&acc)[2][2][4][2], const pg8::Unit& u_, int wr, int wc, int fr, int fq) const {
        pg8::Unit u; u.pm = u_.pm; u.pn = u_.pn; u.z = u_.z; asm volatile("" : "+s"(u.pm), "+s"(u.pn), "+s"(u.z));
        const int b = u.pm >> 4, col0 = u.pn * 256 + wc * 32 + 4 * fq;
        { f32x4 gv[2][2];
#pragma unroll
          for (int bj = 0; bj < 2; ++bj)
#pragma unroll
              for (int n = 0; n < 2; ++n) gv[bj][n] = *(const f32x4*)(gate + (size_t)b * NMOD + col0 + bj * 128 + n * 16);
#pragma unroll
          for (int ai = 0; ai < 2; ++ai)
#pragma unroll
              for (int mp = 0; mp < 2; ++mp) {
                  f32x4 bs[2][2][2];
#pragma unroll
                  for (int mm = 0; mm < 2; ++mm) { const size_t off = (size_t)(u.pm * 256 + ai * 128 + wr * 64 + (2 * mp + mm) * 16 + fr) * DM_ + col0;
#pragma unroll
                      for (int bj = 0; bj < 2; ++bj)
#pragma unroll
                          for (int n = 0; n < 2; ++n) bs[mm][bj][n] = __builtin_nontemporal_load((const f32x4*)(base + off + bj * 128 + n * 16)); }
                  asm volatile("" ::: "memory");
#pragma unroll
                  for (int mm = 0; mm < 2; ++mm) { const int m = 2 * mp + mm; const int row = u.pm * 256 + ai * 128 + wr * 64 + m * 16 + fr; float s = 0.f;
#pragma unroll
                      for (int bj = 0; bj < 2; ++bj)
#pragma unroll
                          for (int n = 0; n < 2; ++n) { const f32x4 y = bs[mm][bj][n] + gv[bj][n] * acc[ai][bj][m][n]; acc[ai][bj][m][n] = y; s += (y.x * y.x + y.y * y.y) + (y.z * y.z + y.w * y.w); }
                      s += __shfl_xor(s, 16); s += __shfl_xor(s, 32);
                      if (fq == 0) atomicAdd(rowsq + row, s); }
                  asm volatile("" ::: "memory"); } }
        xcd_barrier(bar);
        f32x4 Av[2][2], Bv[2][2];
#pragma unroll
        for (int bj = 0; bj < 2; ++bj)
#pragma unroll
            for (int n = 0; n < 2; ++n) { const int c = col0 + bj * 128 + n * 16; Av[bj][n] = *(const f32x4*)(gvec + c);
                if (MODE == 0) { Av[bj][n] = Av[bj][n] * (*(const f32x4*)(mod_sc + (size_t)b * NMOD + c) + 1.0f); Bv[bj][n] = *(const f32x4*)(mod_sh + (size_t)b * NMOD + c); } }
#pragma unroll
        for (int ai = 0; ai < 2; ++ai)
#pragma unroll
            for (int m = 0; m < 4; ++m) { const int row = u.pm * 256 + ai * 128 + wr * 64 + m * 16 + fr; const size_t off = (size_t)row * DM_ + col0;
                const float rstd = 1.f / sqrtf(__hip_atomic_load(rowsq + row, __ATOMIC_RELAXED, __HIP_MEMORY_SCOPE_AGENT) * (1.f / DM_) + EPS_);
#pragma unroll
                for (int bj = 0; bj < 2; ++bj)
#pragma unroll
                    for (int n = 0; n < 2; ++n) { const f32x4 y = acc[ai][bj][m][n];
                        if (MODE == 0) { __builtin_nontemporal_store(y, (f32x4*)(out + off + bj * 128 + n * 16)); const f32x4 h = y * rstd * Av[bj][n] + Bv[bj][n];
                            *(unsigned long long*)(xn + off + bj * 128 + n * 16) = (unsigned long long)pk2(h.x, h.y) | ((unsigned long long)pk2(h.z, h.w) << 32); }
                        else { f32x4 o = y * rstd * Av[bj][n]; if (PROBE_SEL >= 0 && blockIdx.x == 0) o = o + probe_delta; __builtin_nontemporal_store(o, (f32x4*)(out + off + bj * 128 + n * 16)); } } }
        return false;
    }
};

struct Args { const float* in[20]; float* out; unsigned char* ws; int ph_lo, ph_hi, li, coop; };
__global__ void __launch_bounds__(NWAVES * 64, 2) mk_fwd(Args args) {
    extern __shared__ __attribute__((aligned(16))) unsigned char lds[];
    LAS unsigned char* const ldsp = (LAS unsigned char*)lds;
    volatile LAS unsigned* MISC = (volatile LAS unsigned*)(ldsp + MISC_OFF);
    const int tid = threadIdx.x, lane = tid & 63, wave = __builtin_amdgcn_readfirstlane(tid >> 6);
    const int G = gridDim.x, bx = blockIdx.x; const int vcu = (G % 8 == 0) ? (bx % 8) * (G / 8) + bx / 8 : bx;
    unsigned char* ws = args.ws;
    gu32* ctl = (gu32*)(ws + WS_CTL);
    const float *x = args.in[0], *cvec = args.in[1], *ctxp = args.in[2], *c_ctx = args.in[3], *w_ada = args.in[4], *b_ada = args.in[5], *g_norm1 = args.in[6], *w_in = args.in[7],
                *lam_q1 = args.in[8], *lam_k1 = args.in[9], *lam_q2 = args.in[10], *lam_k2 = args.in[11], *g_subln = args.in[12], *w_attn_br = args.in[13], *w_four_br = args.in[14],
                *w_out = args.in[15], *g_norm2 = args.in[16], *w_mlp_in = args.in[17], *w_mlp_out = args.in[18], *g_final = args.in[19];
    float* out = args.out;
    float* MOD = (float*)(ws + WS_MOD);
    for (int u = tid; u < (LDS_BYTES - LDSCTL_OFF) / 4; u += NWAVES * 64) ((LAS unsigned*)(ldsp + LDSCTL_OFF))[u] = 0u;
    __syncthreads();
    XcdBarrier bar = xcd_barrier_post((unsigned*)(ctl + CW_BAR) + args.li * XCD_BAR_WORDS, MISC + 8);
    const int lo = args.ph_lo, hi = args.ph_hi;
    if (PROBE_SEL >= 0 && bx == 0 && tid == 0) MISC[16] = (unsigned)__builtin_amdgcn_s_memrealtime();
    if (PROBE_SEL >= 30 && tid == 0) ((unsigned*)(ws + 8192))[bx] = (unsigned)__builtin_amdgcn_s_memrealtime();
#ifndef PHMASK
#define PHMASK 0xfff
#endif
#define IN(k) ((((PHMASK) >> (k)) & 1) && lo <= (k) && (k) < hi)
#define STAMP(k) do { if (PROBE_SEL >= 0 && bx == 0 && tid == 0) MISC[16 + (k)] = (unsigned)__builtin_amdgcn_s_memrealtime(); } while (0)
#define SEAM(k) do { if (IN(k) && IN((k) + 1)) xcd_barrier(bar); STAMP((k) + 1); } while (0)
    const int gw = bx * NWAVES + wave, NGW = G * NWAVES, gt = bx * (NWAVES * 64) + tid, NGT = G * NWAVES * 64;

    if (IN(0)) {
        LAS float* scr = (LAS float*)(ldsp + RING_OFF + wave * 16384);
        constexpr int I_IN = (DM_ / 64) * (INCOLS / 32), I_AT = (1024 / 64) * (DM_ / 32), I_OUT = (DM_ / 64) * (DM_ / 32);
        constexpr int NITEMS = I_IN + 2 * I_AT + I_OUT;
        for (int it = gw; it < NITEMS; it += NGW) {
            int r = it;
            if (r < I_IN) { p0_transpose_item(w_in, DM_, INCOLS, (bf16*)(ws + WS_WIN), scr, r, lane); continue; } r -= I_IN;
            if (r < I_AT) { p0_transpose_item(w_attn_br, 1024, DM_, (bf16*)(ws + WS_WATT), scr, r, lane); continue; } r -= I_AT;
            if (r < I_AT) { p0_transpose_item(w_four_br, 1024, DM_, (bf16*)(ws + WS_WFOUR), scr, r, lane); continue; } r -= I_AT;
            p0_transpose_item(w_out, DM_, DM_, (bf16*)(ws + WS_WOUT), scr, r, lane);
        }
        { bf16* D = (bf16*)(ws + WS_DFTM);
          STAMP(14);
          LAS float* tab = (LAS float*)(ldsp + RING_OFF);
          __syncthreads();
          for (int j = tid; j < 4096; j += NWAVES * 64) tab[j] = cospif((float)j * (1.0f / 2048.0f));
          __syncthreads();
          for (int idx = gt; idx < 2048 * (FKP / 8); idx += NGT) {     const int lp = idx / (FKP / 8), c8 = (idx - lp * (FKP / 8)) * 8; float cv[8];
              const bool sn = c8 >= FKC; const int kb = sn ? c8 - FKC : c8;
#pragma unroll
              for (int e = 0; e < 8; ++e) { const int j = (lp * (kb + e)) & 4095; cv[e] = tab[sn ? ((j - 1024) & 4095) : j]; }
              v4u oc; oc.x = pk2(cv[0], cv[1]); oc.y = pk2(cv[2], cv[3]); oc.z = pk2(cv[4], cv[5]); oc.w = pk2(cv[6], cv[7]);
              *(GAS v4u*)(D + (size_t)lp * FKP + c8) = oc; } }
        STAMP(15);
        { bf16* CS = (bf16*)(ws + WS_CS);
          for (int idx = gt; idx < 512 * 256; idx += NGT) { const int mrow = idx >> 8, cc = idx & 255, n = mrow & 255; const float xx = (float)((n * cc) & 255) * (1.0f / 128.0f);
              CS[idx] = (bf16)f2bf((mrow >> 8) ? sinpif(xx) : cospif(xx)); } }
        { float* rc = (float*)(ws + WS_ROPEC); float* rs = (float*)(ws + WS_ROPES);
          for (int idx = gt; idx < 1024; idx += NGT) { const int pos = idx >> 4, j = idx & 15; const float inv = powf(10000.0f, -(float)(2 * j) / 32.0f); const float ang = (float)pos * inv; rc[idx] = cosf(ang); rs[idx] = sinf(ang); } }
        { LAS float* sil = (LAS float*)(ldsp + RING_OFF);
          LAS float* red = (LAS float*)(ldsp + RING_OFF + 24576);
          __syncthreads();
          for (int q = tid; q < 3 * 2048; q += NWAVES * 64) { const float v = q < 4096 ? cvec[q] : c_ctx[q - 4096]; sil[q] = v / (1.f + __expf(-v)); }
          __syncthreads();
          for (int blk = bx; blk < 192; blk += G) {
              const int ks = tid >> 4, cq = tid & 15, kbase = ks * 64;
              f32x4 a0 = {0.f, 0.f, 0.f, 0.f}, a1 = a0, a2 = a0;
              const float* wp = w_ada + (size_t)kbase * NMOD + blk * 64 + cq * 4;
#pragma unroll 16
              for (int kk = 0; kk < 64; ++kk) { const f32x4 w = __builtin_nontemporal_load((const f32x4*)(wp + (size_t)kk * NMOD));
                  a0 += w * sil[kbase + kk]; a1 += w * sil[2048 + kbase + kk]; a2 += w * sil[4096 + kbase + kk]; }
              LAS float* rp = red + (ks * 16 + cq) * 12;
#pragma unroll
              for (int e = 0; e < 4; ++e) { rp[e] = a0[e]; rp[4 + e] = a1[e]; rp[8 + e] = a2[e]; }
              __syncthreads();
              if (tid < 192) { float s = 0.f;
#pragma unroll
                  for (int q = 0; q < 32; ++q) s += red[q * 192 + tid];
                  const int cq2 = tid / 12, comp = tid % 12, col = blk * 64 + cq2 * 4 + (comp & 3);
                  MOD[(comp >> 2) * NMOD + col] = s + b_ada[col]; }
              __syncthreads();
          } }
        STAMP(12);
        if (PROBE_SEL >= 20 && PROBE_SEL < 30 && tid == 0) ((unsigned*)(ws + 8192))[bx] = (unsigned)__builtin_amdgcn_s_memrealtime();
        if (IN(1)) { if (args.coop) cg::this_grid().sync(); else xcd_barrier(bar); }
        STAMP(1);
    }
    if (IN(1)) {
        bf16* XN = (bf16*)(ws + WS_XN);
#define P1_LOAD(buf, m) row_load_nt((m) < MTOK ? x + (size_t)(m) * DM_ : ctxp + (size_t)((m) - MTOK) * DM_, lane, buf)
#define P1_BODY(buf, m) do { const float* md = MOD + (size_t)((m) < MTOK ? ((m) >> 12) : 2) * NMOD; norm_mod_store(buf, g_norm1, md, md + DM_, XN + (size_t)(m) * DM_, lane); } while (0)
        {
          const int b = gw & 1; const float* md = MOD + (size_t)b * NMOD; f32x4 Av[8], Bv[8];
#pragma unroll
          for (int j = 0; j < 8; ++j) { Av[j] = ((const GAS f32x4*)g_norm1)[64 * j + lane] * (((const GAS f32x4*)(md + DM_))[64 * j + lane] + 1.0f); Bv[j] = ((const GAS f32x4*)md)[64 * j + lane]; }
#define P1L_LOAD(buf, r) row_load_nt(x + ((size_t)(b * SEQ_ + (r))) * DM_, lane, buf)
#define P1L_BODY(buf, r) do { const float rstd = row_rstd(buf); GAS unsigned long long* o8 = (GAS unsigned long long*)(XN + ((size_t)(b * SEQ_ + (r))) * DM_) + lane; \
            _Pragma("unroll") for (int j = 0; j < 8; ++j) { const f32x4 y = buf[j] * rstd * Av[j] + Bv[j]; o8[64 * j] = (unsigned long long)pk2(y.x, y.y) | ((unsigned long long)pk2(y.z, y.w) << 32); } } while (0)
          ROW_PIPE(gw >> 1, NGW >> 1, SEQ_, P1L_LOAD, P1L_BODY); }
        ROW_PIPE(MTOK + gw, NGW, MTOK + MCTX, P1_LOAD, P1_BODY);
        SEAM(1);
    }
    if (IN(2)) {
        pg8::Gemm g{ws, DM_, DM_, DM_}; pg8::SchedG1 S; S.mp.init(32, 32); S.G = G; S.c = bx; S.offA = WS_XN; S.offB = WS_WIN;
        pg8::EpiG1 E{ws, (const float*)(ws + WS_ROPEC), (const float*)(ws + WS_ROPES)};
        pg8::gemm_phase<pg8::EpiG1, pg8::SchedG1, true, true>(ldsp + RING_OFF, g, S, E);
        SEAM(2);
    }
    if (IN(3)) {
        for (int t = gt; t < 512 * 256; t += NGT) { const int j = t >> 8, c8 = (t & 255) * 8; const float* P = (const float*)(ws + WS_PART) + (size_t)j * 2048 + c8;
            f32x4 s0 = *(const GAS f32x4*)P, s1 = *(const GAS f32x4*)(P + 4);
#pragma unroll
            for (int q = 1; q < 8; ++q) { s0 += *(const GAS f32x4*)(P + (size_t)q * (512 * 2048)); s1 += *(const GAS f32x4*)(P + (size_t)q * (512 * 2048) + 4); }
            bf16* dst = (bf16*)(ws + WS_K + (size_t)(c8 >> 10) * (WS_V - WS_K)) + (size_t)((j >> 8) * 4352 + 4096 + (j & 255)) * 1024 + (c8 & 1023);
            *(GAS v4u*)dst = pg8::pack8(s0, s1); }
        { const bf16* Fb = (const bf16*)(ws + WS_F); bf16* FE = (bf16*)(ws + WS_FE); bf16* FO = (bf16*)(ws + WS_FO);
          for (int t = gt; t < 2 * 2304 * 128; t += NGT) { const int c8 = (t & 127) * 8, rk = t >> 7, b = rk / 2304, kk = rk - b * 2304;
              f32x4 a0 = {0.f, 0.f, 0.f, 0.f}, a1 = a0, c0 = a0, c1 = a0;
              if (kk <= 2048) pg8::unpack8(__builtin_nontemporal_load((const v4u*)(Fb + ((size_t)(b * 4096 + kk)) * 1024 + c8)), a0, a1);
              if (kk >= 1 && kk < 2048) pg8::unpack8(__builtin_nontemporal_load((const v4u*)(Fb + ((size_t)(b * 4096 + 4096 - kk)) * 1024 + c8)), c0, c1);
              *(GAS v4u*)(FE + ((size_t)(b * 2304 + kk)) * 1024 + c8) = pg8::pack8(a0 + c0, a1 + c1);
              if (kk < 2048) { if (kk == 0) { a0 = c0; a1 = c1; } *(GAS v4u*)(FO + ((size_t)(b * 2048 + kk)) * 1024 + c8) = pg8::pack8(a0 - c0, a1 - c1); } } }
        xcd_barrier(bar);
        pg8::Gemm g{ws, 256, 1024, 256}; pg8::SchedF1 S{G, bx, WS_CS, WS_FE, WS_FO};
        pg8::EpiF1 E{(bf16*)(ws + WS_TT)};
        pg8::gemm_phase<pg8::EpiF1, pg8::SchedF1, true, false>(ldsp + RING_OFF, g, S, E);
        SEAM(3);
    }
    if (IN(4)) {
        const attn_body::bf16 *Qb = (const attn_body::bf16*)(ws + WS_Q), *Kb = (const attn_body::bf16*)(ws + WS_K), *Vb = (const attn_body::bf16*)(ws + WS_V);
        for (int i = 0; ; ++i) { const int L = i * G + vcu; if (L >= 512) break;
            const int prob = (L & 255) >> 3, qb = ((L >> 8) << 3) | (L & 7), b = prob >> 4, h = (prob >> 1) & 7, c = prob & 1;
            attn_body::bf16* Ob = (attn_body::bf16*)(ws + WS_O0 + (size_t)c * (WS_O1 - WS_O0));
            attn_body::attn_unit<8>(Qb + ((size_t)(b * SEQ_ + qb * 256)) * 1024 + (h * 2 + c) * 64, Kb + (size_t)b * 4352 * 1024 + (h * 2 + c) * 64, Vb + (size_t)b * 4352 * 1024 + h * 128,
                                    Ob + ((size_t)(b * SEQ_ + qb * 256)) * 1024 + h * 128, (char*)lds + RING_OFF);
        }
        asm volatile("s_waitcnt vmcnt(0) lgkmcnt(0)" ::: "memory"); __syncthreads();
        STAMP(13);
        for (int w2 = gw; w2 < 2048; w2 += NGW) { const int b = w2 >> 10, ch = w2 & 1023; const bf16* row = (const bf16*)(ws + WS_TT) + ((size_t)((b * 4 + (ch >> 8)) * 256 + (ch & 255))) * FKP;
            float s = 0.f;
#pragma unroll
            for (int q = 0; q < 4; ++q) { f32x4 e0, e1; pg8::unpack8(*(const GAS v4u*)(row + lane * 32 + q * 8), e0, e1); s += (e0.x - e0.y) + (e0.z - e0.w) + (e1.x - e1.y) + (e1.z - e1.w); }
            s = wave_sum(s) + __uint_as_float((unsigned)row[2048] << 16);
            if (lane == 0) ((float*)(ws + WS_Y2048))[w2] = s; }
        pg8::Gemm g{ws, FKP, FKP, FKP}; pg8::SchedF2 S{G, bx, WS_DFTM, WS_TT};
        pg8::EpiF2 E{(bf16*)(ws + WS_YC)};
        pg8::gemm_phase<pg8::EpiF2, pg8::SchedF2, true, false>(ldsp + RING_OFF, g, S, E);
        SEAM(4);
    }
    if (IN(5)) {
        const float lam = __expf(wave_sum(lam_q1[lane] * lam_k1[lane])) - __expf(wave_sum(lam_q2[lane] * lam_k2[lane])) + LAM_INIT;
        const bf16 *O0 = (const bf16*)(ws + WS_O0), *O1 = (const bf16*)(ws + WS_O1); bf16 *AA = (bf16*)(ws + WS_AATT), *YB = (bf16*)(ws + WS_YB);
        const bf16* Yp = (const bf16*)(ws + WS_YC); const float* Y2048 = (const float*)(ws + WS_Y2048);
        f32x4 gs[4];
#pragma unroll
        for (int j = 0; j < 4; ++j) gs[j] = ((const GAS f32x4*)g_subln)[(lane & 7) * 4 + j] * (1.0f - LAM_INIT);
#define P5_LOAD(buf, m) do { const size_t off_ = (size_t)(m) * 1024 + lane * 16; \
            buf[0] = __builtin_nontemporal_load((const f32x4*)(O0 + off_)); buf[1] = __builtin_nontemporal_load((const f32x4*)(O0 + off_ + 8)); buf[2] = __builtin_nontemporal_load((const f32x4*)(O1 + off_)); buf[3] = __builtin_nontemporal_load((const f32x4*)(O1 + off_ + 8)); \
            const int lq_ = (m) & 4095, ls_ = lq_ < 2048 ? lq_ : (lq_ == 2048 ? 0 : 4096 - lq_); const size_t yo_ = ((size_t)(((m) >> 12) * 2048 + ls_)) * 1024 + lane * 16; \
            _Pragma("unroll") for (int p_ = 0; p_ < 4; ++p_) { buf[4 + 2 * p_] = __builtin_nontemporal_load((const f32x4*)(Yp + (size_t)p_ * (4096 * 1024) + yo_)); buf[5 + 2 * p_] = __builtin_nontemporal_load((const f32x4*)(Yp + (size_t)p_ * (4096 * 1024) + yo_ + 8)); } } while (0)
#define P5_BODY(buf, m) do { const size_t off = (size_t)(m) * 1024 + lane * 16; \
            f32x4 o[4], p[4]; pg8::unpack8(__builtin_bit_cast(v4u, buf[0]), o[0], o[1]); pg8::unpack8(__builtin_bit_cast(v4u, buf[1]), o[2], o[3]); \
            pg8::unpack8(__builtin_bit_cast(v4u, buf[2]), p[0], p[1]); pg8::unpack8(__builtin_bit_cast(v4u, buf[3]), p[2], p[3]); \
            float ss = 0.f; \
            _Pragma("unroll") for (int j = 0; j < 4; ++j) { o[j] = o[j] - p[j] * lam; ss += (o[j].x * o[j].x + o[j].y * o[j].y) + (o[j].z * o[j].z + o[j].w * o[j].w); } \
            ss += __shfl_xor(ss, 1); ss += __shfl_xor(ss, 2); ss += __shfl_xor(ss, 4); \
            const float r = 1.f / sqrtf(ss * (1.f / 128.f) + EPS_); \
            _Pragma("unroll") for (int j = 0; j < 4; ++j) o[j] = o[j] * r * gs[j]; \
            *(GAS v4u*)(AA + off) = pg8::pack8(o[0], o[1]); *(GAS v4u*)(AA + off + 8) = pg8::pack8(o[2], o[3]); \
            f32x4 y[4], q[4], t[4]; const int lq = (m) & 4095; const float sg = lq < 2048 ? -1.0f : 1.0f;     \
            pg8::unpack8(__builtin_bit_cast(v4u, buf[4]), y[0], y[1]); pg8::unpack8(__builtin_bit_cast(v4u, buf[5]), y[2], y[3]); pg8::unpack8(__builtin_bit_cast(v4u, buf[6]), t[0], t[1]); pg8::unpack8(__builtin_bit_cast(v4u, buf[7]), t[2], t[3]); \
            _Pragma("unroll") for (int j = 0; j < 4; ++j) y[j] = y[j] + t[j]; \
            pg8::unpack8(__builtin_bit_cast(v4u, buf[8]), q[0], q[1]); pg8::unpack8(__builtin_bit_cast(v4u, buf[9]), q[2], q[3]); pg8::unpack8(__builtin_bit_cast(v4u, buf[10]), t[0], t[1]); pg8::unpack8(__builtin_bit_cast(v4u, buf[11]), t[2], t[3]); \
            _Pragma("unroll") for (int j = 0; j < 4; ++j) y[j] = (y[j] + sg * (q[j] + t[j])) * (1.0f / 1024.0f); \
            if (lq == 2048) { _Pragma("unroll") for (int j = 0; j < 4; ++j) y[j] = *(const GAS f32x4*)(Y2048 + ((m) >> 12) * 1024 + lane * 16 + 4 * j) * (1.0f / 1024.0f); } \
            *(GAS v4u*)(YB + off) = pg8::pack8(y[0], y[1]); *(GAS v4u*)(YB + off + 8) = pg8::pack8(y[2], y[3]); } while (0)
        ROW_PIPE_N(12, gw, NGW, MTOK, P5_LOAD, P5_BODY);
        {
          LAS float* scr = (LAS float*)(ldsp + RING_OFF + wave * 16384);
          constexpr int I_1 = (DM_ / 64) * (DFF / 32), I_2 = (DFF / 64) * (DM_ / 32);
          for (int it = gw; it < I_1 + I_2; it += NGW) {
              if (it < I_1) p0_transpose_item(w_mlp_in, DM_, DFF, (bf16*)(ws + WS_WIN), scr, it, lane);
              else p0_transpose_item(w_mlp_out, DFF, DM_, (bf16*)(ws + WS_TT), scr, it - I_1, lane);
          } }
        SEAM(5);
    }
    if (IN(6)) {
        pg8::Gemm g{ws, 1024, 1024, 1024}; pg8::SchedMerged S; S.mp.init(32, 8); S.G = G; S.c = bx; S.offA0 = WS_AATT; S.offB0 = WS_WATT; S.offA1 = WS_YB; S.offB1 = WS_WFOUR;
        pg8::EpiMerged E{(const bf16*)(ws + WS_SGA), (const bf16*)(ws + WS_SGF), (bf16*)(ws + WS_MB)};
        pg8::gemm_phase<pg8::EpiMerged, pg8::SchedMerged, true, true>(ldsp + RING_OFF, g, S, E);
        SEAM(6);
    }
    if (IN(7)) {
        pg8::Gemm g{ws, DM_, DM_, DM_}; pg8::SchedTiles S; S.mp.init(32, 8); S.G = G; S.c = bx; S.nt = DM_ / 64; S.offA = WS_MB; S.offB = WS_WOUT; S.tA = (size_t)256 * DM_ * 2; S.tB = (size_t)256 * DM_ * 2;
        EpiResNorm<0> E{x, (float*)(ws + WS_XMID), MOD + 2 * DM_, (float*)(ws + WS_ROWSQ1), g_norm2, MOD + 4 * DM_, MOD + 3 * DM_, (bf16*)(ws + WS_XN), bar, 0.f};
        pg8::gemm_phase<EpiResNorm<0>, pg8::SchedTiles, true, true>(ldsp + RING_OFF, g, S, E);
        SEAM(7);
    }
    STAMP(9);
    if (IN(9)) {
        pg8::Gemm g{ws, DM_, DM_, DM_}; pg8::SchedTiles S; S.mp.init(32, 32); S.G = G; S.c = bx; S.nt = DM_ / 64; S.offA = WS_XN; S.offB = WS_WIN; S.tA = (size_t)256 * DM_ * 2; S.tB = (size_t)256 * DM_ * 2;
        pg8::EpiRelu2 E{(bf16*)(ws + WS_Z)};
        pg8::gemm_phase<pg8::EpiRelu2, pg8::SchedTiles, true, true>(ldsp + RING_OFF, g, S, E);
        SEAM(9);
    }
    if (IN(10)) {
        float probe_delta = 0.f;
        if (PROBE_SEL >= 0 && bx == 0) { float T_us;
            if (PROBE_SEL < 20) T_us = (float)(MISC[16 + (PROBE_SEL >= 0 && PROBE_SEL < 16 ? PROBE_SEL : 0)] - MISC[16]) * 0.01f;
            else { const unsigned* st = (const unsigned*)(ws + 8192); const unsigned t0 = MISC[16]; unsigned mx = 0, amx = 0, mn = 0xffffffffu, cnt = 0;
                for (int q = 0; q < G; ++q) { const unsigned d = st[q] - t0; if (d > mx) { mx = d; amx = q; } if (d < mn) mn = d; if (d > 6000u) ++cnt; }
                T_us = PROBE_SEL == 20 ? mx * 0.01f : PROBE_SEL == 21 ? (float)amx : PROBE_SEL == 22 ? mn * 0.01f : (float)cnt; }
            probe_delta = sqrtf(T_us * 2.56e-6f); }
        pg8::Gemm g{ws, DFF, DFF, DFF}; pg8::SchedTiles S; S.mp.init(32, 8); S.G = G; S.c = bx; S.nt = DFF / 64; S.offA = WS_Z; S.offB = WS_TT; S.tA = (size_t)256 * DFF * 2; S.tB = (size_t)256 * DFF * 2;
        EpiResNorm<1> E{(const float*)(ws + WS_XMID), out, MOD + 5 * DM_, (float*)(ws + WS_ROWSQ2), g_final, nullptr, nullptr, nullptr, bar, probe_delta};
        pg8::gemm_phase<EpiResNorm<1>, pg8::SchedTiles, true, true>(ldsp + RING_OFF, g, S, E);
    }
#undef IN
#undef SEAM
}

constexpr int NPHASE = 12;
extern "C" void kernel_launch(void* const* d_in, const int* in_sizes, int n_in, void* d_out, int out_size, void* d_ws, size_t ws_size, hipStream_t stream) {
    static int grid = 0;
    if (grid == 0) {
        if (n_in != 20 || in_sizes[0] != MTOK * DM_ || out_size != MTOK * DM_ || ws_size < WS_END) { fprintf(stderr, "kernel_launch: unexpected shapes / workspace (n_in %d, in0 %d, out %d, ws %zu, need %zu)\n", n_in, n_in > 0 ? in_sizes[0] : -1, out_size, ws_size, (size_t)WS_END); grid = -1; return; }
        int dev = 0, cus = 0, per_cu = 0;
        if (hipGetDevice(&dev) != hipSuccess || hipDeviceGetAttribute(&cus, hipDeviceAttributeMultiprocessorCount, dev) != hipSuccess) { fprintf(stderr, "kernel_launch: device query failed\n"); grid = -1; return; }
        if (hipFuncSetAttribute((const void*)mk_fwd, hipFuncAttributeMaxDynamicSharedMemorySize, LDS_BYTES) != hipSuccess) { fprintf(stderr, "kernel_launch: hipFuncSetAttribute failed\n"); grid = -1; return; }
        if (hipOccupancyMaxActiveBlocksPerMultiprocessor(&per_cu, (const void*)mk_fwd, NWAVES * 64, LDS_BYTES) != hipSuccess || per_cu < 1) { fprintf(stderr, "kernel_launch: occupancy query says %d blocks per CU\n", per_cu); per_cu = 1; }
        (void)hipGetLastError();
        grid = cus;
        if (cus != 256) { fprintf(stderr, "kernel_launch: built for a 256-CU device (one 256x256 tile per workgroup in the fused-norm GEMM phases); found %d CUs\n", cus); grid = -1; return; }
    }
    if (grid < 0) return;
    if (hipMemsetAsync((char*)d_ws + WS_CTL, 0, CTL_ZERO_BYTES, stream) != hipSuccess) { fprintf(stderr, "kernel_launch: memset failed\n"); return; }
    Args a{};
    for (int i = 0; i < 20; ++i) a.in[i] = (const float*)d_in[i];
    a.out = (float*)d_out; a.ws = (unsigned char*)d_ws; a.ph_lo = 0; a.ph_hi = NPHASE; a.li = 0; a.coop = 0;
    void* kargs[] = {&a};
    const hipError_t le = hipLaunchCooperativeKernel((const void*)mk_fwd, dim3(grid), dim3(NWAVES * 64), kargs, LDS_BYTES, stream);
    if (le != hipSuccess) fprintf(stderr, "kernel_launch: cooperative launch failed: %s (grid %d)\n", hipGetErrorString(le), grid);
}
```

```cpp
#include <hip/hip_cooperative_groups.h>
namespace cg = cooperative_groups;
#include <cstddef>
constexpr int NWAVES = 8;
constexpr int DM_ = 2048, SEQ_ = 4096, BATCH_ = 2, CTXL = 256, MTOK = BATCH_ * SEQ_  , MCTX = BATCH_ * CTXL  , INCOLS = 8192, DFF = 8192, NMOD = 6 * DM_  ;
constexpr float EPS_ = 1e-6f, LAM_INIT = 0.2f;
constexpr size_t MiB = 1u << 20;
constexpr size_t WS_CTL = 0, CTL_ZERO_BYTES = 1 * MiB;
constexpr size_t WS_MOD = 256 * 1024;
constexpr size_t WS_ROWSQ1 = 512 * 1024, WS_ROWSQ2 = 576 * 1024;
constexpr size_t WS_Y2048 = 1 * MiB + 384 * 1024;
constexpr size_t WS_YC = 50 * MiB, WS_YS = 66 * MiB;
constexpr size_t WS_MB = 84 * MiB;
constexpr size_t WS_XMID = 310 * MiB;
constexpr size_t WS_ROPEC = 1 * MiB, WS_ROPES = 1 * MiB + 4096, WS_CS = 1 * MiB + 65536;
constexpr size_t WS_WATT = 2 * MiB, WS_WFOUR = 6 * MiB, WS_WOUT = 10 * MiB;
constexpr size_t WS_WIN = 18 * MiB;
constexpr size_t WS_XN = 50 * MiB;
constexpr size_t WS_DFTM = 84 * MiB;
constexpr size_t WS_Q = 148 * MiB, WS_K = 164 * MiB, WS_V = 181 * MiB, WS_F = 198 * MiB, WS_SGA = 214 * MiB, WS_SGF = 246 * MiB;
constexpr size_t WS_AATT = WS_Q, WS_YB = WS_K, WS_Z = WS_Q;
constexpr size_t WS_TT = 278 * MiB;
constexpr size_t WS_O0 = 310 * MiB, WS_O1 = 326 * MiB;
constexpr size_t WS_FE = WS_O0, WS_FO = WS_O1;
constexpr int FKC = 2176, FKS = 2048, FKP = FKC + FKS;
constexpr size_t WS_PART = 342 * MiB, WS_END = 374 * MiB;
constexpr int CW_BAR = 4096;
constexpr int RING_OFF = 0, RING_BYTES = 131072;
constexpr int LDSCTL_OFF = RING_BYTES, MISC_OFF = LDSCTL_OFF + 320;
constexpr int LDS_BYTES = 147456;
static_assert(MISC_OFF + 128 <= LDS_BYTES, "LDS map");
#include <hip/hip_runtime.h>
#include <cstdio>
#include <cstdint>
namespace pg8 {
#define PG8_LAS __attribute__((address_space(3)))
typedef unsigned short bf16_t;
typedef short bf16x8 __attribute__((ext_vector_type(8)));
typedef float f32x4 __attribute__((ext_vector_type(4)));
typedef unsigned u32x4 __attribute__((ext_vector_type(4)));
constexpr int BM = 256, BK = 64, HALF = 128, HTB = HALF * BK * 2  , STAGE_BYTES = 8 * HTB, NXCD = 8, WGM = 8;

__host__ __device__ __forceinline__ int lds_byte(int r, int c) { const int st = (r >> 4) * 2 + (c >> 5), rr = r & 15, cc = c & 31, ob = rr * 64 + cc * 2; return st * 1024 + (ob ^ (((ob >> 9) & 1) << 5)); }
__host__ __device__ __forceinline__ void stage_rc(int b, int& R, int& C) { const int st = b / 1024, sb = b % 1024, swz = sb ^ (((sb >> 9) & 1) << 5); R = (st >> 1) * 16 + swz / 64; C = (st & 1) * 32 + (swz % 64) / 2; }
__host__ __device__ __forceinline__ int perm32(int rho) { const int n = rho >> 4, i = rho & 15; return 8 * (i >> 2) + 4 * n + (i & 3); }

struct Unit { int pm, pn, z, nt; size_t aoff, boff; };
struct Gemm { const unsigned char* base; int lda, ldb, K; };
__device__ __forceinline__ unsigned cvt_pk_bf16(float lo, float hi) { unsigned r; asm volatile("v_cvt_pk_bf16_f32 %0, %1, %2" : "=v"(r) : "v"(lo), "v"(hi)); return r; }
__device__ __forceinline__ u32x4 pack8(const f32x4 v0, const f32x4 v1) { u32x4 w; w.x = cvt_pk_bf16(v0[0], v0[1]); w.y = cvt_pk_bf16(v0[2], v0[3]); w.z = cvt_pk_bf16(v1[0], v1[1]); w.w = cvt_pk_bf16(v1[2], v1[3]); return w; }
__device__ __forceinline__ void st16_nt(void* p, const u32x4 v) { __builtin_nontemporal_store(v, (u32x4*)p); }
__device__ __forceinline__ void unpack8(const u32x4 w, f32x4& v0, f32x4& v1) {
    v0[0] = __uint_as_float(w.x << 16); v0[1] = __uint_as_float(w.x & 0xffff0000u); v0[2] = __uint_as_float(w.y << 16); v0[3] = __uint_as_float(w.y & 0xffff0000u);
    v1[0] = __uint_as_float(w.z << 16); v1[1] = __uint_as_float(w.z & 0xffff0000u); v1[2] = __uint_as_float(w.w << 16); v1[3] = __uint_as_float(w.w & 0xffff0000u); }

struct Map2D {
    int nM, nN, nwg;
    __device__ __forceinline__ void init(int nM_, int nN_) { nM = nM_; nN = nN_; nwg = nM_ * nN_; }
    __device__ __forceinline__ void map(int L, int& pm, int& pn) const {
        int wgid = L; { const int q = nwg / NXCD, r = nwg % NXCD, xcd = wgid % NXCD, off = wgid / NXCD; wgid = (xcd < r ? xcd * (q + 1) : r * (q + 1) + (xcd - r) * q) + off; }
        const int nig = WGM * nN, gid = wgid / nig, fm = gid * WGM, gsz = (nM - fm) < WGM ? (nM - fm) : WGM;
        pm = fm + ((wgid % nig) % gsz); pn = (wgid % nig) / gsz;
    }
};
struct SchedTiles {
    Map2D mp; int G, c, nt; size_t offA, offB, tA, tB;
    __device__ __forceinline__ bool next(int i, Unit& u) const { const int L = i * G + c; if (L >= mp.nwg) return false; mp.map(L, u.pm, u.pn); u.z = 0; u.nt = nt; u.aoff = offA + (size_t)u.pm * tA; u.boff = offB + (size_t)u.pn * tB; return true; }
};
struct SchedG1 {
    Map2D mp; int G, c; size_t offA, offB;
    __device__ __forceinline__ bool next(int i, Unit& u) const { const int L = i * G + c;
        int kq = 0;
        if (L < 1024) { mp.map(L, u.pm, u.pn); u.z = 0; u.nt = 32;
            { const int xi = (u.pn >> 4) * 4 + ((u.pn >> 2) & 3), r = ((u.pn >> 2) + u.pn) & 3; u.pn = r == 0 ? xi : (r == 1 ? 8 + xi : 16 + xi * 2 + (r & 1)); } }
        else { const int e = L - 1024; if (e >= 128) return false; const int tile = e >> 3; kq = e & 7; u.pm = 32 + (tile >> 3); u.pn = 4 + (tile & 7); u.z = 1 + kq; u.nt = 4; }
        u.aoff = offA + (size_t)u.pm * (256 * 2048 * 2) + (size_t)kq * 512; u.boff = offB + (size_t)u.pn * (256 * 2048 * 2) + (size_t)kq * 512; return true; }
};
struct SchedF1 {
    int G, c; size_t offCS, offFE, offFO;
    __device__ __forceinline__ bool next(int i, Unit& u) const { const int L = i * G + c; if (L >= 136) return false; u.pm = 0; u.nt = 4;
        if (L < 72) { const int g = L / 18, r = L % 18, b = r / 9; u.pn = r % 9; u.z = g | (b << 2); u.aoff = offCS; u.boff = offFE + ((size_t)(b * 2304 + u.pn * 256) * 1024 + (size_t)g * 256) * 2; }
        else { const int e = L - 72, g = e >> 4, r = e & 15, b = r >> 3; u.pn = r & 7; u.z = g | (b << 2) | 8; u.aoff = offCS + (size_t)(256 * 256 * 2); u.boff = offFO + ((size_t)(b * 2048 + u.pn * 256) * 1024 + (size_t)g * 256) * 2; }
        return true; }
};
struct SchedF2 {
    int G, c; size_t offD, offT;
    __device__ __forceinline__ bool next(int i, Unit& u) const { const int L = i * G + c; if (L >= 256) return false;
        const int idx = L >> 3, p = idx & 3, bg = idx >> 2, koff = (p >> 1) * FKC + (p & 1) * 1024; u.pm = L & 7; u.pn = 0; u.z = (bg << 2) | p; u.nt = p == 1 ? 18 : 16;
        u.aoff = offD + ((size_t)u.pm * 256 * FKP + (size_t)koff) * 2; u.boff = offT + ((size_t)bg * 256 * FKP + (size_t)koff) * 2; return true; }
};
struct SchedMerged {
    Map2D mp; int G, c; size_t offA0, offB0, offA1, offB1;
    __device__ __forceinline__ bool next(int i, Unit& u) const { const int L = (i >> 1) * G + c; if (L >= mp.nwg) return false; mp.map(L, u.pm, u.pn); u.z = i & 1; u.nt = 16;
        u.aoff = (u.z ? offA1 : offA0) + (size_t)u.pm * (256 * 1024 * 2); u.boff = (u.z ? offB1 : offB0) + (size_t)u.pn * (256 * 1024 * 2); return true; }
};

constexpr float QSCALE = 0.125f * 1.4426950408889634f;
struct EpiG1 {
    static constexpr bool PERM = true;
    unsigned char* ws; const float *ropec, *ropes;
    __device__ __forceinline__ bool operator()(f32x4 (&acc)[2][2][4][2], const Unit& u_, int wr, int wc, int fr, int fq) const {
        Unit u; u.pm = u_.pm; u.pn = u_.pn; u.z = u_.z; asm volatile("" : "+s"(u.pm), "+s"(u.pn), "+s"(u.z));
        const int type = u.pn >> 2;
        const bool ctx = u.pm >= 32;
        if (type <= 1 && !ctx) {
            bf16_t* O = (bf16_t*)(ws + WS_Q + (size_t)type * (WS_K - WS_Q)); const float sc = type == 0 ? QSCALE : 1.f;
            const int cl = (u.pn & 3) * 256 + wc * 32 + 8 * fq;
#pragma unroll
            for (int ai = 0; ai < 2; ++ai)
#pragma unroll
                for (int m = 0; m < 4; ++m) {
                    const int tok = u.pm * BM + ai * HALF + wr * 64 + m * 16 + fr, b = tok >> 12, l = tok & 4095;
                    const int pos = (wc & 1) ? (l & 63) : (l >> 6);
                    const float* cp = ropec + pos * 16 + 8 * (fq & 1); const float* sp = ropes + pos * 16 + 8 * (fq & 1);
                    const f32x4 c0 = *(const f32x4*)cp, c1 = *(const f32x4*)(cp + 4); f32x4 s0 = *(const f32x4*)sp, s1 = *(const f32x4*)(sp + 4);
                    if (fq < 2) { s0 = -s0; s1 = -s1; }
                    const size_t orow = type == 0 ? (size_t)tok : (size_t)(b * 4352 + l);
                    bf16_t* rowp = O + orow * 1024 + cl;
#pragma unroll
                    for (int bj = 0; bj < 2; ++bj) { const f32x4 v0 = acc[ai][bj][m][0], v1 = acc[ai][bj][m][1]; f32x4 p0, p1;
#pragma unroll
                        for (int j = 0; j < 4; ++j) {
                            const auto r0 = __builtin_amdgcn_permlane32_swap(__float_as_uint(v0[j]), __float_as_uint(v0[j]), false, false); p0[j] = __uint_as_float(fq < 2 ? r0[1] : r0[0]);
                            const auto r1 = __builtin_amdgcn_permlane32_swap(__float_as_uint(v1[j]), __float_as_uint(v1[j]), false, false); p1[j] = __uint_as_float(fq < 2 ? r1[1] : r1[0]); }
                        const f32x4 o0 = (v0 * c0 + p0 * s0) * sc, o1 = (v1 * c1 + p1 * s1) * sc;
                        *(u32x4*)(rowp + bj * HALF) = pack8(o0, o1); }
                }
        } else if (ctx) {
            float* P = (float*)(ws + WS_PART) + (size_t)(u.z - 1) * (512 * 2048) + (u.pn - 4) * 256 + wc * 32 + 8 * fq;
#pragma unroll
            for (int ai = 0; ai < 2; ++ai)
#pragma unroll
                for (int m = 0; m < 4; ++m) { float* rowp = P + (size_t)((u.pm - 32) * BM + ai * HALF + wr * 64 + m * 16 + fr) * 2048;
#pragma unroll
                    for (int bj = 0; bj < 2; ++bj) { *(f32x4*)(rowp + bj * HALF) = acc[ai][bj][m][0]; *(f32x4*)(rowp + bj * HALF + 4) = acc[ai][bj][m][1]; } }
        } else if (type <= 3) {
            bf16_t* O = (bf16_t*)(ws + WS_K + (size_t)(type - 1) * (WS_V - WS_K));
            const int cl = (u.pn & 3) * 256 + wc * 32 + 8 * fq;
#pragma unroll
            for (int ai = 0; ai < 2; ++ai)
#pragma unroll
                for (int m = 0; m < 4; ++m) {
                    const int r = u.pm * BM + ai * HALF + wr * 64 + m * 16 + fr; size_t orow;
                    if (type == 3) orow = (size_t)r;
                    else orow = (size_t)((r >> 12) * 4352 + (r & 4095));
                    bf16_t* rowp = O + orow * 1024 + cl;
#pragma unroll
                    for (int bj = 0; bj < 2; ++bj) *(u32x4*)(rowp + bj * HALF) = pack8(acc[ai][bj][m][0], acc[ai][bj][m][1]);
                }
        } else {
            bf16_t* O = (bf16_t*)(ws + WS_SGA + (size_t)((type - 4) >> 1) * (WS_SGF - WS_SGA));
            const int cl = (u.pn & 7) * 256 + wc * 32 + 8 * fq;
#pragma unroll
            for (int ai = 0; ai < 2; ++ai)
#pragma unroll
                for (int m = 0; m < 4; ++m) {
                    const int r = u.pm * BM + ai * HALF + wr * 64 + m * 16 + fr; bf16_t* rowp = O + (size_t)r * 2048 + cl;
#pragma unroll
                    for (int bj = 0; bj < 2; ++bj) { f32x4 v0 = acc[ai][bj][m][0], v1 = acc[ai][bj][m][1];
#pragma unroll
                        for (int j = 0; j < 4; ++j) { v0[j] = __builtin_amdgcn_rcpf(1.f + __expf(-v0[j])); v1[j] = __builtin_amdgcn_rcpf(1.f + __expf(-v1[j])); }
                        st16_nt(rowp + bj * HALF, pack8(v0, v1)); }
                }
        }
        return false;
    }
};
struct EpiF1 {
    static constexpr bool PERM = true;
    bf16_t* TT;
    __device__ __forceinline__ bool operator()(f32x4 (&acc)[2][2][4][2], const Unit& u_, int wr, int wc, int fr, int fq) const {
        Unit u; u.pm = u_.pm; u.pn = u_.pn; u.z = u_.z; asm volatile("" : "+s"(u.pm), "+s"(u.pn), "+s"(u.z));
        const int g = u.z & 3, b = (u.z >> 2) & 1, cs = u.z >> 3;
#pragma unroll
        for (int ai = 0; ai < 2; ++ai)
#pragma unroll
            for (int m = 0; m < 4; ++m) { const int n = ai * HALF + wr * 64 + m * 16 + fr;
#pragma unroll
                for (int bj = 0; bj < 2; ++bj) { const int k0 = u.pn * BM + bj * HALF + wc * 32 + 8 * fq;
                    if (cs || k0 < FKC) *(u32x4*)(TT + ((size_t)((b * 4 + g) * 256 + n)) * FKP + cs * FKC + k0) = pack8(acc[ai][bj][m][0], acc[ai][bj][m][1]); } }
        return false;
    }
};
struct EpiF2 {
    static constexpr bool PERM = true;
    bf16_t* Y0;
    __device__ __forceinline__ bool operator()(f32x4 (&acc)[2][2][4][2], const Unit& u_, int wr, int wc, int fr, int fq) const {
        Unit u; u.pm = u_.pm; u.pn = u_.pn; u.z = u_.z; asm volatile("" : "+s"(u.pm), "+s"(u.pn), "+s"(u.z));
        const int p = u.z & 3, bg = u.z >> 2, b = bg >> 2, g = bg & 3; bf16_t* Y = Y0 + (size_t)p * (4096 * 1024);
#pragma unroll
        for (int ai = 0; ai < 2; ++ai)
#pragma unroll
            for (int m = 0; m < 4; ++m) { const int lp = u.pm * BM + ai * HALF + wr * 64 + m * 16 + fr; bf16_t* rowp = Y + ((size_t)(b * 2048 + lp)) * 1024 + g * 256 + wc * 32 + 8 * fq;
#pragma unroll
                for (int bj = 0; bj < 2; ++bj) *(u32x4*)(rowp + bj * HALF) = pack8(acc[ai][bj][m][0], acc[ai][bj][m][1]); }
        return false;
    }
};
struct EpiMerged {
    static constexpr bool PERM = true;
    const bf16_t *SGA, *SGF; bf16_t* Mb;
    __device__ __forceinline__ bool operator()(f32x4 (&acc)[2][2][4][2], const Unit& u_, int wr, int wc, int fr, int fq) const {
        Unit u; u.pm = u_.pm; u.pn = u_.pn; u.z = u_.z; asm volatile("" : "+s"(u.pm), "+s"(u.pn), "+s"(u.z));
        const int cl = u.pn * BM + wc * 32 + 8 * fq;
#pragma unroll
        for (int ai = 0; ai < 2; ++ai)
#pragma unroll
            for (int mp = 0; mp < 2; ++mp) {
                u32x4 gf[2][2], ga[2][2];
#pragma unroll
                for (int mm = 0; mm < 2; ++mm) { const size_t off = (size_t)(u.pm * BM + ai * HALF + wr * 64 + (2 * mp + mm) * 16 + fr) * 2048 + cl;
#pragma unroll
                    for (int bj = 0; bj < 2; ++bj) { gf[mm][bj] = __builtin_nontemporal_load((const u32x4*)(SGF + off + bj * HALF)); if (u.z == 0) ga[mm][bj] = __builtin_nontemporal_load((const u32x4*)(SGA + off + bj * HALF)); } }
                asm volatile("" ::: "memory");
#pragma unroll
                for (int mm = 0; mm < 2; ++mm) { const int m = 2 * mp + mm; const size_t off = (size_t)(u.pm * BM + ai * HALF + wr * 64 + m * 16 + fr) * 2048 + cl;
#pragma unroll
                    for (int bj = 0; bj < 2; ++bj) { f32x4 f0, f1; unpack8(gf[mm][bj], f0, f1);
                        if (u.z == 0) { f32x4 a0, a1; unpack8(ga[mm][bj], a0, a1);
#pragma unroll
                            for (int j = 0; j < 4; ++j) { acc[ai][bj][m][0][j] *= a0[j] * __builtin_amdgcn_rcpf(f0[j]); acc[ai][bj][m][1][j] *= a1[j] * __builtin_amdgcn_rcpf(f1[j]); }
                        } else *(u32x4*)(Mb + off + bj * HALF) = pack8(acc[ai][bj][m][0] * f0, acc[ai][bj][m][1] * f1); } }
                asm volatile("" ::: "memory"); }
        return u.z == 0;
    }
};
struct EpiRes {
    static constexpr bool PERM = false;
    const float* base; float* out; const float* gate;
    __device__ __forceinline__ bool operator()(f32x4 (&acc)[2][2][4][2], const Unit& u_, int wr, int wc, int fr, int fq) const {
        Unit u; u.pm = u_.pm; u.pn = u_.pn; u.z = u_.z; asm volatile("" : "+s"(u.pm), "+s"(u.pn), "+s"(u.z));
        const int b = u.pm >> 4, col0 = u.pn * BM + wc * 32 + 4 * fq; f32x4 gv[2][2];
#pragma unroll
        for (int bj = 0; bj < 2; ++bj)
#pragma unroll
            for (int n = 0; n < 2; ++n) gv[bj][n] = *(const f32x4*)(gate + (size_t)b * 12288 + col0 + bj * HALF + n * 16);
#pragma unroll
        for (int ai = 0; ai < 2; ++ai)
#pragma unroll
            for (int m = 0; m < 4; ++m) { const size_t off = (size_t)(u.pm * BM + ai * HALF + wr * 64 + m * 16 + fr) * 2048 + col0;
#pragma unroll
                for (int bj = 0; bj < 2; ++bj)
#pragma unroll
                    for (int n = 0; n < 2; ++n) *(f32x4*)(out + off + bj * HALF + n * 16) = *(const f32x4*)(base + off + bj * HALF + n * 16) + gv[bj][n] * acc[ai][bj][m][n]; }
        return false;
    }
};
struct EpiRelu2 {
    static constexpr bool PERM = true;
    bf16_t* Z;
    __device__ __forceinline__ bool operator()(f32x4 (&acc)[2][2][4][2], const Unit& u_, int wr, int wc, int fr, int fq) const {
        Unit u; u.pm = u_.pm; u.pn = u_.pn; u.z = u_.z; asm volatile("" : "+s"(u.pm), "+s"(u.pn), "+s"(u.z));
        const int cl = u.pn * BM + wc * 32 + 8 * fq;
#pragma unroll
        for (int ai = 0; ai < 2; ++ai)
#pragma unroll
            for (int m = 0; m < 4; ++m) { bf16_t* rowp = Z + (size_t)(u.pm * BM + ai * HALF + wr * 64 + m * 16 + fr) * 8192 + cl;
#pragma unroll
                for (int bj = 0; bj < 2; ++bj) { f32x4 v0 = acc[ai][bj][m][0], v1 = acc[ai][bj][m][1];
#pragma unroll
                    for (int j = 0; j < 4; ++j) { const float a = fmaxf(v0[j], 0.f), c = fmaxf(v1[j], 0.f); v0[j] = a * a; v1[j] = c * c; }
                    *(u32x4*)(rowp + bj * HALF) = pack8(v0, v1); } }
        return false;
    }
};
template <class Epi, class Sched, bool ALIGN_EPI = false, bool SP2 = false>
__device__ __forceinline__ void gemm_phase(PG8_LAS unsigned char* lds, const Gemm g, const Sched& S, const Epi& E) {
    const int tid = threadIdx.x, wid = __builtin_amdgcn_readfirstlane(tid >> 6), lane = tid & 63, wr = wid >> 2, wc = wid & 3, fr = lane & 15, fq = lane >> 4;
    unsigned voffA[2], voffB[2];
#pragma unroll
    for (int i = 0; i < 2; ++i) { int R, C; stage_rc(tid * 16 + i * 8192, R, C); const int Rb = Epi::PERM ? ((R & ~31) + perm32(R & 31)) : R;
        voffA[i] = (unsigned)(R * g.lda + C) * 2u; voffB[i] = (unsigned)(Rb * g.ldb + C) * 2u; }
    const size_t kstep = (size_t)(BK * 2);
    const size_t hstepA = (size_t)HALF * g.lda * 2, hstepB = (size_t)HALF * g.ldb * 2;
    const unsigned ldsw = (unsigned)wid * 1024u;
    const int aoff = lds_byte(wr * 64 + fr, fq * 8), boff = lds_byte(wc * 32 + fr, fq * 8);
#define PG8_SA(b, h) (((b) * 2 + (h)) * HTB)
#define PG8_SB(b, h) ((4 + (b) * 2 + (h)) * HTB)
#define PG8_STAGE(bufoff, gbase, voff) do { _Pragma("unroll") for (int _i = 0; _i < 2; ++_i) \
        __builtin_amdgcn_global_load_lds((const unsigned*)((const char*)(gbase) + (voff)[_i]), (PG8_LAS unsigned*)(lds + (bufoff) + ldsw + _i * 8192), 16, 0, 0); } while (0)
#define PG8_LDA(dst, b, h) do { _Pragma("unroll") for (int m = 0; m < 4; ++m) _Pragma("unroll") for (int k = 0; k < 2; ++k) dst[m][k] = *(const PG8_LAS bf16x8*)(lds + PG8_SA(b, h) + aoff + m * 2048 + k * 1024); } while (0)
#define PG8_LDB(dst, b, h) do { _Pragma("unroll") for (int n = 0; n < 2; ++n) _Pragma("unroll") for (int k = 0; k < 2; ++k) dst[n][k] = *(const PG8_LAS bf16x8*)(lds + PG8_SB(b, h) + boff + n * 2048 + k * 1024); } while (0)
#define PG8_MMA(ai, bj, At, Bt) do { __builtin_amdgcn_s_setprio(1); _Pragma("unroll") for (int m = 0; m < 4; ++m) _Pragma("unroll") for (int n = 0; n < 2; ++n) _Pragma("unroll") for (int k = 0; k < 2; ++k) \
        acc[ai][bj][m][n] = __builtin_amdgcn_mfma_f32_16x16x32_bf16(Bt[n][k], At[m][k], acc[ai][bj][m][n], 0, 0, 0); __builtin_amdgcn_s_setprio(0); } while (0)
#define PG8_WAIT_V(n) asm volatile("s_waitcnt vmcnt(" #n ")" ::: "memory")
#define PG8_WAIT_L(n) asm volatile("s_waitcnt lgkmcnt(" #n ")" ::: "memory")
#define PG8_BAR __builtin_amdgcn_s_barrier()
#define PG8_SCHED __builtin_amdgcn_sched_barrier(0)
    Unit cur, nxt; int ui = 0;
    if (!S.next(0, cur)) return;
    f32x4 acc[2][2][4][2];
#pragma unroll
    for (int a = 0; a < 2; ++a)
#pragma unroll
        for (int b = 0; b < 2; ++b)
#pragma unroll
            for (int m = 0; m < 4; ++m)
#pragma unroll
                for (int n = 0; n < 2; ++n) acc[a][b][m][n] = (f32x4){0.f, 0.f, 0.f, 0.f};
    bf16x8 At[4][2], B0[2][2], B1[2][2];
    const char* cA = (const char*)g.base + cur.aoff; const char* cB = (const char*)g.base + cur.boff;

    if constexpr (SP2) {
        PG8_STAGE(PG8_SB(0, 0), cB, voffB); PG8_STAGE(PG8_SB(0, 1), cB + hstepB, voffB); PG8_STAGE(PG8_SA(0, 0), cA, voffA); PG8_STAGE(PG8_SA(0, 1), cA + hstepA, voffA);
        if (wr == 1) PG8_BAR;
        PG8_WAIT_V(2); PG8_BAR;
        PG8_STAGE(PG8_SB(1, 0), cB + kstep, voffB); PG8_STAGE(PG8_SA(1, 0), cA + kstep, voffA); PG8_STAGE(PG8_SB(1, 1), cB + hstepB + kstep, voffB);
        PG8_WAIT_V(6); PG8_BAR;
    } else {
        PG8_STAGE(PG8_SB(0, 0), cB, voffB); PG8_STAGE(PG8_SA(0, 0), cA, voffA); PG8_STAGE(PG8_SB(0, 1), cB + hstepB, voffB); PG8_STAGE(PG8_SA(0, 1), cA + hstepA, voffA);
        if (wr == 1) PG8_BAR;
        PG8_WAIT_V(4); PG8_BAR;
        PG8_STAGE(PG8_SB(1, 0), cB + kstep, voffB); PG8_STAGE(PG8_SA(1, 0), cA + kstep, voffA); PG8_STAGE(PG8_SB(1, 1), cB + hstepB + kstep, voffB);
        PG8_WAIT_V(6); PG8_BAR;
    }
    for (;;) {
        const bool has_next = S.next(ui + 1, nxt);
        const char* nA = has_next ? (const char*)g.base + nxt.aoff : cA; const char* nB = has_next ? (const char*)g.base + nxt.boff : cB;
        int nt = cur.nt; asm volatile("" : "+s"(nt));
        for (int t = 0; t < nt; t += 2) {
            const bool last = (t == nt - 2);
            const char* a1 = cA + (size_t)(t + 1) * kstep;
            const char* a2 = last ? nA : cA + (size_t)(t + 2) * kstep; const char* b2 = last ? nB : cB + (size_t)(t + 2) * kstep;
            const char* a3 = a2 + kstep; const char* b3 = b2 + kstep;

            if constexpr (SP2) {
            PG8_LDB(B0, 0, 0); PG8_LDB(B1, 0, 1); PG8_SCHED; PG8_LDA(At, 0, 0); PG8_STAGE(PG8_SA(1, 1), a1 + hstepA, voffA);
            PG8_WAIT_V(8); PG8_WAIT_L(0); PG8_BAR; PG8_MMA(0, 0, At, B0); PG8_MMA(0, 1, At, B1); PG8_BAR; PG8_SCHED;
            PG8_LDA(At, 0, 1); PG8_STAGE(PG8_SB(0, 0), b2, voffB); PG8_STAGE(PG8_SB(0, 1), b2 + hstepB, voffB); PG8_STAGE(PG8_SA(0, 0), a2, voffA);
            PG8_WAIT_V(8); PG8_WAIT_L(0); PG8_BAR; PG8_MMA(1, 0, At, B0); PG8_MMA(1, 1, At, B1); PG8_BAR; PG8_SCHED;
            PG8_LDB(B0, 1, 0); PG8_LDB(B1, 1, 1); PG8_SCHED; PG8_LDA(At, 1, 0); PG8_STAGE(PG8_SA(0, 1), a2 + hstepA, voffA);
            PG8_WAIT_V(8); PG8_WAIT_L(0); PG8_BAR; PG8_MMA(0, 0, At, B0); PG8_MMA(0, 1, At, B1); PG8_BAR; PG8_SCHED;
            PG8_LDA(At, 1, 1); PG8_STAGE(PG8_SB(1, 0), b3, voffB); PG8_STAGE(PG8_SB(1, 1), b3 + hstepB, voffB); PG8_STAGE(PG8_SA(1, 0), a3, voffA);
            PG8_WAIT_V(8); PG8_WAIT_L(0); PG8_BAR; PG8_MMA(1, 0, At, B0); PG8_MMA(1, 1, At, B1); PG8_BAR; PG8_SCHED;
            } else {
            PG8_LDB(B0, 0, 0); PG8_SCHED; PG8_LDA(At, 0, 0); PG8_STAGE(PG8_SA(1, 1), a1 + hstepA, voffA);
            PG8_WAIT_L(8); PG8_BAR; PG8_WAIT_L(0); PG8_MMA(0, 0, At, B0); PG8_BAR; PG8_SCHED;
            PG8_LDB(B1, 0, 1); PG8_STAGE(PG8_SB(0, 0), b2, voffB);
            PG8_BAR; PG8_WAIT_L(0); PG8_MMA(0, 1, At, B1); PG8_BAR;
            PG8_LDA(At, 0, 1); PG8_STAGE(PG8_SA(0, 0), a2, voffA);
            PG8_BAR; PG8_WAIT_L(0); PG8_MMA(1, 0, At, B0); PG8_BAR; PG8_SCHED;
            PG8_STAGE(PG8_SB(0, 1), b2 + hstepB, voffB);
            PG8_WAIT_V(6); PG8_BAR; PG8_MMA(1, 1, At, B1); PG8_BAR;
            PG8_LDB(B0, 1, 0); PG8_SCHED; PG8_LDA(At, 1, 0); PG8_STAGE(PG8_SA(0, 1), a2 + hstepA, voffA);
            PG8_WAIT_L(8); PG8_BAR; PG8_WAIT_L(0); PG8_MMA(0, 0, At, B0); PG8_BAR; PG8_SCHED;
            PG8_LDB(B1, 1, 1); PG8_STAGE(PG8_SB(1, 0), b3, voffB);
            PG8_BAR; PG8_WAIT_L(0); PG8_MMA(0, 1, At, B1); PG8_BAR;
            PG8_LDA(At, 1, 1); PG8_STAGE(PG8_SA(1, 0), a3, voffA);
            PG8_BAR; PG8_WAIT_L(0); PG8_MMA(1, 0, At, B0); PG8_BAR; PG8_SCHED;
            PG8_STAGE(PG8_SB(1, 1), b3 + hstepB, voffB);
            PG8_WAIT_V(6); PG8_BAR; PG8_MMA(1, 1, At, B1); PG8_BAR;
            }
        }
        if constexpr (ALIGN_EPI) { if (wr == 0) PG8_BAR; }
        const bool keep = E(acc, cur, wr, wc, fr, fq);
        if (!has_next) break;
        if (!keep)
#pragma unroll
        for (int a = 0; a < 2; ++a)
#pragma unroll
            for (int b = 0; b < 2; ++b)
#pragma unroll
                for (int m = 0; m < 4; ++m)
#pragma unroll
                    for (int n = 0; n < 2; ++n) acc[a][b][m][n] = (f32x4){0.f, 0.f, 0.f, 0.f};
        cur = nxt; cA = nA; cB = nB; ++ui;
        if constexpr (ALIGN_EPI) { if (wr == 1) PG8_BAR; }
    }
    PG8_WAIT_V(0);
    if constexpr (!ALIGN_EPI) { if (wr == 0) PG8_BAR; }
    PG8_BAR;
#undef PG8_SA
#undef PG8_SB
#undef PG8_STAGE
#undef PG8_LDA
#undef PG8_LDB
#undef PG8_MMA
#undef PG8_WAIT_V
#undef PG8_WAIT_L
#undef PG8_BAR
#undef PG8_SCHED
}
}
#include <hip/hip_bf16.h>
#include <cmath>
namespace attn_body {
using bf16=__hip_bfloat16;
using bf16x8=__attribute__((ext_vector_type(8)))short;
using s16x4=__attribute__((ext_vector_type(4)))short;
using f32x16=__attribute__((ext_vector_type(16)))float;
using u32x4=__attribute__((ext_vector_type(4)))unsigned;
constexpr int BATCH=2,NHEAD=16,SEQ=4096,LK=4352,D=64,DM=NHEAD*D;
constexpr int NW=8,QBLK=32,QB=QBLK*NW,KVBLK=64,NQB=SEQ/QB;
constexpr int ATTN_PITCH=DM, ATTN_UNIT_ROWS=QB;
__device__ __forceinline__ int crow(int r,int hi){return (r&3)+8*(r>>2)+4*hi;}
#define SBAR() __builtin_amdgcn_sched_barrier(0)
constexpr int NSLOT=3, SLOTB=8192;
constexpr int LDS_K=0, LDS_V=NSLOT*SLOTB, LDS_WS=LDS_V+NSLOT*2*SLOTB, LDS_OST=LDS_WS+NW*64*4, LDS_BYTES=LDS_OST+NW*4096;
constexpr float C2=0.125f*1.4426950408889634f;
__device__ __forceinline__ void glds16(const void*gsrc,unsigned lds_dst){unsigned keep;
  asm volatile("s_mov_b32 %0, m0\n\ts_mov_b32 m0, %2\n\ts_nop 0\n\tglobal_load_lds_dwordx4 %1, off\n\ts_mov_b32 m0, %0":"=&s"(keep):"v"(gsrc),"s"(lds_dst):"memory");}
__device__ __forceinline__ float max3f(float a,float b,float c){float r;asm("v_max3_f32 %0, %1, %2, %3":"=v"(r):"v"(a),"v"(b),"v"(c));return r;}
__device__ __forceinline__ float max2f(float a,float b){float r;asm("v_max_f32_e32 %0, %1, %2":"=v"(r):"v"(a),"v"(b));return r;}
__device__ __forceinline__ float fadd_s(float a,float b){float r;asm("v_add_f32_e32 %0, %1, %2":"=v"(r):"v"(a),"v"(b));return r;}
__device__ __forceinline__ float fsub_s(float a,float b){float r;asm("v_sub_f32_e32 %0, %1, %2":"=v"(r):"v"(a),"v"(b));return r;}
typedef float f32x2_t __attribute__((ext_vector_type(2))); typedef __bf16 bf16x2_t __attribute__((ext_vector_type(2)));
__device__ __forceinline__ unsigned cvtpk_s(float lo,float hi){f32x2_t v={lo,hi};bf16x2_t b=__builtin_convertvector(v,bf16x2_t);return __builtin_bit_cast(unsigned,b);}
#define WAIT_BAR(N) asm volatile("s_waitcnt vmcnt(" #N ") lgkmcnt(0)\n\ts_barrier":::"memory")

__device__ __forceinline__ void qkt(f32x16&p0,f32x16&p1,const char*Kslot,const bf16x8*qr,const f32x16&negm,int r32,int hi){
  const char*kb=Kslot+hi*1024+r32*16;
  #pragma unroll
  for(int d0=0;d0<4;++d0){
    const bf16x8 b0=*reinterpret_cast<const bf16x8*>(kb+d0*2048);
    const bf16x8 b1=*reinterpret_cast<const bf16x8*>(kb+d0*2048+512);
    if(d0==0){p0=__builtin_amdgcn_mfma_f32_32x32x16_bf16(b0,qr[0],negm,0,0,0);p1=__builtin_amdgcn_mfma_f32_32x32x16_bf16(b1,qr[0],negm,0,0,0);}
    else{p0=__builtin_amdgcn_mfma_f32_32x32x16_bf16(b0,qr[d0],p0,0,0,0);p1=__builtin_amdgcn_mfma_f32_32x32x16_bf16(b1,qr[d0],p1,0,0,0);}}
}
typedef __attribute__((address_space(3))) const char* lds_cptr;
typedef short v4i16_t __attribute__((ext_vector_type(4)));
__device__ __forceinline__ void kload8(bf16x8*kf,lds_cptr kp){
  kf[0]=*(const __attribute__((address_space(3))) bf16x8*)(kp);      kf[1]=*(const __attribute__((address_space(3))) bf16x8*)(kp+512);
  kf[2]=*(const __attribute__((address_space(3))) bf16x8*)(kp+2048); kf[3]=*(const __attribute__((address_space(3))) bf16x8*)(kp+2560);
  kf[4]=*(const __attribute__((address_space(3))) bf16x8*)(kp+4096); kf[5]=*(const __attribute__((address_space(3))) bf16x8*)(kp+4608);
  kf[6]=*(const __attribute__((address_space(3))) bf16x8*)(kp+6144); kf[7]=*(const __attribute__((address_space(3))) bf16x8*)(kp+6656);
}
__device__ __forceinline__ void kload2(bf16x8*kf,lds_cptr kp,int j){ kf[2*j]=*(const __attribute__((address_space(3))) bf16x8*)(kp+j*2048); kf[2*j+1]=*(const __attribute__((address_space(3))) bf16x8*)(kp+j*2048+512); }
__device__ __forceinline__ s16x4 vtr(lds_cptr p){ return __builtin_bit_cast(s16x4,__builtin_amdgcn_ds_read_tr16_b64_v4i16((__attribute__((address_space(3))) v4i16_t*)p)); }
__device__ __forceinline__ float rowmax(const f32x16&p0,const f32x16&p1){
  float a=max3f(p0[0],p0[1],p1[0]),b=max3f(p0[2],p0[3],p1[1]);a=max3f(a,p1[2],p1[3]);
  #pragma unroll
  for(int r=4;r<16;r+=4){a=max3f(a,p0[r],p0[r+1]);b=max3f(b,p0[r+2],p0[r+3]);a=max3f(a,p1[r],p1[r+1]);b=max3f(b,p1[r+2],p1[r+3]);}
  const float m=max2f(a,b);
  auto rr=__builtin_amdgcn_permlane32_swap(__float_as_uint(m),__float_as_uint(m),false,false);
  return max2f(__uint_as_float(rr[0]),__uint_as_float(rr[1]));
}
__device__ __forceinline__ void pv(f32x16*o,int vb,bf16x8 pa0,bf16x8 pa1,bf16x8 pa2,bf16x8 pa3){
  #pragma unroll
  for(int d0=0;d0<4;++d0){s16x4 lo[4],hi[4];
    #pragma unroll
    for(int ks=0;ks<4;++ks){
      asm volatile("ds_read_b64_tr_b16 %0,%1 offset:%c2":"=&v"(lo[ks]):"v"(vb),"i"(d0*4096+ks*1024):"memory");
      asm volatile("ds_read_b64_tr_b16 %0,%1 offset:%c2":"=&v"(hi[ks]):"v"(vb),"i"(d0*4096+ks*1024+512):"memory");}
    asm volatile("s_waitcnt lgkmcnt(0)":::"memory");SBAR();
    #define PK(k) (bf16x8){lo[k][0],lo[k][1],lo[k][2],lo[k][3],hi[k][0],hi[k][1],hi[k][2],hi[k][3]}
    o[d0]=__builtin_amdgcn_mfma_f32_32x32x16_bf16(pa0,PK(0),o[d0],0,0,0);
    o[d0]=__builtin_amdgcn_mfma_f32_32x32x16_bf16(pa1,PK(1),o[d0],0,0,0);
    o[d0]=__builtin_amdgcn_mfma_f32_32x32x16_bf16(pa2,PK(2),o[d0],0,0,0);
    o[d0]=__builtin_amdgcn_mfma_f32_32x32x16_bf16(pa3,PK(3),o[d0],0,0,0);
    #undef PK
  }
}

#ifndef ATTN_STORE16
#define ATTN_STORE16(p,v) (*(u32x4*)(p)=(v))
#endif
template<int THRL> __device__ __forceinline__ void attn_unit(const bf16*Qu,const bf16*__restrict__ Kh,const bf16*__restrict__ Vh,bf16*Ou,char*shm){
  const int tid=threadIdx.x,lane=tid&63,r32=lane&31,hi=lane>>5; const int wid=__builtin_amdgcn_readfirstlane(tid>>6);
  const bf16*Qw=Qu+(long)wid*QBLK*DM;
  const unsigned lds0=(unsigned)(uintptr_t)shm;
  float*wsf=(float*)(shm+LDS_WS)+wid*64;
  const bf16*ksrc=Kh+(long)lane*DM+wid*8;
  const bf16*vsrc=Vh+(long)(16*(wid&3)+(lane>>2))*DM+(wid>>2)*32+(lane&3)*8;
  const unsigned kdst=lds0+LDS_K+wid*1024, vdst=lds0+LDS_V+wid*1024;
  #define DMA_K(t,slot) glds16(ksrc+(long)(t)*KVBLK*DM,(unsigned)__builtin_amdgcn_readfirstlane(kdst+(slot)))
  #define DMA_V(t,slot) do{ glds16(vsrc+(long)(t)*KVBLK*DM,(unsigned)__builtin_amdgcn_readfirstlane(vdst+2*(slot))); glds16(vsrc+(long)(t)*KVBLK*DM+64,(unsigned)__builtin_amdgcn_readfirstlane(vdst+2*(slot)+8192)); }while(0)
  const int vb0=(int)(lds0+LDS_V)+((lane>>4)&1)*32+(lane&3)*8+(4*hi+((lane&15)>>2))*64;
  const char*Kbase=shm+LDS_K; bf16x8 kf[8];
  const lds_cptr shm3=(lds_cptr)shm; const lds_cptr kp0=shm3+LDS_K+hi*1024+r32*16; const lds_cptr vp0=shm3+LDS_V+((lane>>4)&1)*32+(lane&3)*8+(4*hi+((lane&15)>>2))*64;
  constexpr int NT=LK/KVBLK;
  DMA_K(0,0);DMA_V(0,0);DMA_K(1,SLOTB);
  bf16x8 qr[4];
  #pragma unroll
  for(int d0=0;d0<4;++d0)qr[d0]=*reinterpret_cast<const bf16x8*>(&Qw[(long)r32*DM+d0*16+hi*8]);
  float mhat=0.f,l_reg=0.f;f32x16 o[4];o[0]=f32x16{};o[1]=f32x16{};o[2]=f32x16{};o[3]=f32x16{};float nm=0.f;
  #define CMASK(P0,P1,t) do{}while(0)
  bool resc=false;
  #define START(P0,P1) do{ const float rm=rowmax(P0,P1); resc=false; \
    { const float dl=rm; mhat=fadd_s(mhat,dl); \
      _Pragma("unroll") for(int r=0;r<16;++r){P0[r]=fsub_s(P0[r],dl);P1[r]=fsub_s(P1[r],dl);} \
      nm=-mhat; } \
    _Pragma("unroll") for(int r=0;r<16;++r)P0[r]=__builtin_amdgcn_exp2f(P0[r]); }while(0)
  #define RESC() do{ if(resc){ asm volatile("s_waitcnt lgkmcnt(0)":::"memory"); \
      _Pragma("unroll") for(int d_=0;d_<4;++d_) _Pragma("unroll") for(int r=0;r<16;++r)o[d_][r]*=wsf[crow(r,hi)]; } }while(0)
  f32x16 pA0,pA1,pB0,pB1;
  int sl_prev=0,sl_cur=0,sl_next=SLOTB;
  #define ROT() do{sl_prev=sl_cur;sl_cur=sl_next;sl_next=(sl_next==(NSLOT-1)*SLOTB)?0:sl_next+SLOTB;}while(0)
  DMA_K(2,2*SLOTB);
  WAIT_BAR(4);
  { f32x16 T0_; _Pragma("unroll") for(int r=0;r<16;++r)T0_[r]=nm; qkt(pA0,pA1,Kbase,qr,T0_,r32,hi); }asm volatile("s_nop 15\n\ts_nop 7":"+v"(pA0),"+v"(pA1));CMASK(pA0,pA1,0);
  START(pA0,pA1);
  _Pragma("unroll") for(int r=0;r<16;++r)pA1[r]=__builtin_amdgcn_exp2f(pA1[r]);
  WAIT_BAR(0);
  DMA_K(3,0);DMA_V(1,SLOTB);
  ROT();
  kload8(kf,kp0+sl_cur);
  WAIT_BAR(3);
  s16x4 vlo[8],vhi[8]; u32x4 pw0,pw1,pw2,pw3;
  #define PKW(P,B) cvtpk_s(P[B],P[B+1])
  #define PAF(k) __builtin_bit_cast(bf16x8,pw##k)
  #define VFR(i) (bf16x8){vlo[i][0],vlo[i][1],vlo[i][2],vlo[i][3],vhi[i][0],vhi[i][1],vhi[i][2],vhi[i][3]}
  #define PIN(x) asm volatile("":"+v"(x))
  #define MX3(a,b,c) __builtin_fmaxf(__builtin_fmaxf((a),(b)),(c))
  #define GAPA(MF,A0,A1,A2,A3,W0,W1,PW) do{ MF; sacc+=A0; sacc+=A1; sacc+=A2; sacc+=A3; PIN(sacc); W0; W1; PIN(PW); SBAR(); }while(0)
  #define EX(v) __builtin_amdgcn_exp2f(v)
  #define GAPB(MF,X,B) do{ MF; X[B]=EX(X[B]); X[B+1]=EX(X[B+1]); PIN(X); SBAR(); }while(0)
  #define VRD(i,d0,ks) do{ vlo[i]=vtr(vp_+((d0)*4096+(ks)*1024)); vhi[i]=vtr(vp_+((d0)*4096+(ks)*1024+512)); }while(0)
  #define KRD(G,j) do{ if(G){ kload2(kf,kp0+sl_next,j); SBAR(); } }while(0)
  #define STEP(C0,C1,P0,P1,t,GK,GV,GL) do{ SBAR(); \
    const lds_cptr vp_=vp0+2*sl_prev; f32x16 T_; _Pragma("unroll") for(int r=0;r<16;++r)T_[r]=nm; \
    VRD(0,0,0); SBAR(); float sacc=(P0[0]+P0[1]); \
    GAPA(C0=__builtin_amdgcn_mfma_f32_32x32x16_bf16(kf[0],qr[0],T_,0,0,0), P0[2],P0[3],P0[4],P0[5],     pw0[0]=PKW(P0,0), pw0[1]=PKW(P0,2), pw0); \
    GAPA(C1=__builtin_amdgcn_mfma_f32_32x32x16_bf16(kf[1],qr[0],T_,0,0,0), P0[6],P0[7],P0[8],P0[9],     pw0[2]=PKW(P0,4), pw0[3]=PKW(P0,6), pw0); \
    VRD(1,1,0); SBAR(); GAPA(C0=__builtin_amdgcn_mfma_f32_32x32x16_bf16(kf[2],qr[1],C0,0,0,0),   P0[10],P0[11],P0[12],P0[13], pw1[0]=PKW(P0,8), pw1[1]=PKW(P0,10), pw1); \
    GAPA(C1=__builtin_amdgcn_mfma_f32_32x32x16_bf16(kf[3],qr[1],C1,0,0,0),   P0[14],P0[15],P1[0],P1[1],   pw1[2]=PKW(P0,12),pw1[3]=PKW(P0,14), pw1); \
    VRD(2,0,1); SBAR(); GAPA(C0=__builtin_amdgcn_mfma_f32_32x32x16_bf16(kf[4],qr[2],C0,0,0,0),   P1[2],P1[3],P1[4],P1[5],     pw2[0]=PKW(P1,0), pw2[1]=PKW(P1,2), pw2); \
    GAPA(C1=__builtin_amdgcn_mfma_f32_32x32x16_bf16(kf[5],qr[2],C1,0,0,0),   P1[6],P1[7],P1[8],P1[9],     pw2[2]=PKW(P1,4), pw2[3]=PKW(P1,6), pw2); \
    VRD(3,1,1); SBAR(); GAPA(C0=__builtin_amdgcn_mfma_f32_32x32x16_bf16(kf[6],qr[3],C0,0,0,0),   P1[10],P1[11],P1[12],P1[13], pw3[0]=PKW(P1,8), pw3[1]=PKW(P1,10), pw3); \
    GAPA(C1=__builtin_amdgcn_mfma_f32_32x32x16_bf16(kf[7],qr[3],C1,0,0,0),   P1[14],P1[15],0.f,0.f,       pw3[2]=PKW(P1,12),pw3[3]=PKW(P1,14), pw3); \
    l_reg+=sacc; \
    if(GK){DMA_K((t)+3,sl_cur);} if(GV){DMA_V((t)+1,sl_next);} \
    CMASK(C0,C1,t); \
    { float a=MX3(C0[0],C0[1],C1[0]),b=MX3(C0[2],C0[3],C1[1]); a=MX3(a,C1[2],C1[3]); \
      _Pragma("unroll") for(int r=4;r<16;r+=4){a=MX3(a,C0[r],C0[r+1]);b=MX3(b,C0[r+2],C0[r+3]);a=MX3(a,C1[r],C1[r+1]);b=MX3(b,C1[r+2],C1[r+3]);} \
      float rm=__builtin_fmaxf(a,b); { auto rr=__builtin_amdgcn_permlane32_swap(__float_as_uint(rm),__float_as_uint(rm),false,false); rm=__builtin_fmaxf(__uint_as_float(rr[0]),__uint_as_float(rr[1])); } \
      resc=false; \
      if(__builtin_expect(__any(rm>(float)THRL),0)){ const float dl=__builtin_fmaxf(rm,0.f); mhat+=dl; \
        _Pragma("unroll") for(int r=0;r<16;++r){C0[r]-=dl;C1[r]-=dl;} \
        nm=-mhat; \
        const float f=__builtin_amdgcn_exp2f(-dl); l_reg*=f; if(hi==0)wsf[r32]=f; resc=true; } } \
    SBAR(); \
      \
    VRD(4,0,2); SBAR(); GAPB(o[0]=__builtin_amdgcn_mfma_f32_32x32x16_bf16(PAF(0),VFR(0),o[0],0,0,0), C0,0); \
    VRD(5,1,2); SBAR(); GAPB(o[1]=__builtin_amdgcn_mfma_f32_32x32x16_bf16(PAF(0),VFR(1),o[1],0,0,0), C0,2); \
    VRD(6,0,3); SBAR(); GAPB(o[0]=__builtin_amdgcn_mfma_f32_32x32x16_bf16(PAF(1),VFR(2),o[0],0,0,0), C0,4); \
    VRD(7,1,3); SBAR(); GAPB(o[1]=__builtin_amdgcn_mfma_f32_32x32x16_bf16(PAF(1),VFR(3),o[1],0,0,0), C0,6); \
      \
    KRD(GL,0); GAPB(o[0]=__builtin_amdgcn_mfma_f32_32x32x16_bf16(PAF(2),VFR(4),o[0],0,0,0), C0,8);  VRD(0,2,0); SBAR(); \
    KRD(GL,1); GAPB(o[1]=__builtin_amdgcn_mfma_f32_32x32x16_bf16(PAF(2),VFR(5),o[1],0,0,0), C0,10); VRD(1,3,0); SBAR(); \
    KRD(GL,2); GAPB(o[0]=__builtin_amdgcn_mfma_f32_32x32x16_bf16(PAF(3),VFR(6),o[0],0,0,0), C0,12); VRD(2,2,1); SBAR(); \
    KRD(GL,3); GAPB(o[1]=__builtin_amdgcn_mfma_f32_32x32x16_bf16(PAF(3),VFR(7),o[1],0,0,0), C0,14); VRD(3,3,1); SBAR(); \
      \
    GAPB(o[2]=__builtin_amdgcn_mfma_f32_32x32x16_bf16(PAF(0),VFR(0),o[2],0,0,0), C1,0);  VRD(4,2,2); SBAR(); \
    GAPB(o[3]=__builtin_amdgcn_mfma_f32_32x32x16_bf16(PAF(0),VFR(1),o[3],0,0,0), C1,2);  VRD(5,3,2); SBAR(); \
    GAPB(o[2]=__builtin_amdgcn_mfma_f32_32x32x16_bf16(PAF(1),VFR(2),o[2],0,0,0), C1,4);  VRD(6,2,3); SBAR(); \
    GAPB(o[3]=__builtin_amdgcn_mfma_f32_32x32x16_bf16(PAF(1),VFR(3),o[3],0,0,0), C1,6);  VRD(7,3,3); SBAR(); \
      \
    GAPB(o[2]=__builtin_amdgcn_mfma_f32_32x32x16_bf16(PAF(2),VFR(4),o[2],0,0,0), C1,8); \
    GAPB(o[3]=__builtin_amdgcn_mfma_f32_32x32x16_bf16(PAF(2),VFR(5),o[3],0,0,0), C1,10); \
    GAPB(o[2]=__builtin_amdgcn_mfma_f32_32x32x16_bf16(PAF(3),VFR(6),o[2],0,0,0), C1,12); \
    GAPB(o[3]=__builtin_amdgcn_mfma_f32_32x32x16_bf16(PAF(3),VFR(7),o[3],0,0,0), C1,14); \
    }while(0)
  int t=1;
  #undef CMASK
  #define CMASK(P0,P1,t) do{}while(0)
  for(;t+5<NT;t+=2){
    STEP(pB0,pB1,pA0,pA1,t,true,true,true);     WAIT_BAR(3); RESC(); ROT();
    STEP(pA0,pA1,pB0,pB1,t+1,true,true,true);   WAIT_BAR(3); RESC(); ROT();
  }
  #undef CMASK
  #define CMASK(P0,P1,t) do{}while(0)
  #define ENDW(tt) do{ if((tt)+3<NT){WAIT_BAR(3);} else if((tt)+2<NT){WAIT_BAR(2);} else {WAIT_BAR(0);} }while(0)
  for(;t+1<NT;t+=2){
    STEP(pB0,pB1,pA0,pA1,t,(t+3<NT),(t+1<NT),(t+1<NT));       ENDW(t);   RESC(); ROT();
    STEP(pA0,pA1,pB0,pB1,t+1,(t+4<NT),(t+2<NT),(t+2<NT));     ENDW(t+1); RESC(); ROT();
  }
  STEP(pB0,pB1,pA0,pA1,NT-1,false,false,false); RESC();
  { float sacc=pB0[0]+pB0[1]; _Pragma("unroll") for(int r=2;r<16;++r)sacc+=pB0[r]; _Pragma("unroll") for(int r=0;r<16;++r)sacc+=pB1[r]; l_reg+=sacc;
    pw0=(u32x4){PKW(pB0,0),PKW(pB0,2),PKW(pB0,4),PKW(pB0,6)};pw1=(u32x4){PKW(pB0,8),PKW(pB0,10),PKW(pB0,12),PKW(pB0,14)};pw2=(u32x4){PKW(pB1,0),PKW(pB1,2),PKW(pB1,4),PKW(pB1,6)};pw3=(u32x4){PKW(pB1,8),PKW(pB1,10),PKW(pB1,12),PKW(pB1,14)};
    SBAR(); pv(o,vb0+2*sl_cur,PAF(0),PAF(1),PAF(2),PAF(3)); }
  #undef PKW
  #undef PAF
  #undef VFR
  #undef PIN
  #undef MX3
  #undef GAPA
  #undef GAPB
  #undef EX
  #undef VRD
  #undef KRD
  #undef STEP
  #undef ENDW
  {auto rr=__builtin_amdgcn_permlane32_swap(__float_as_uint(l_reg),__float_as_uint(l_reg),false,false);l_reg=__uint_as_float(rr[0])+__uint_as_float(rr[1]);}
  if(hi==0)wsf[32+r32]=l_reg;asm volatile("s_waitcnt lgkmcnt(0)":::"memory");
  float rli[16];
  #pragma unroll
  for(int r=0;r<16;++r)rli[r]=__builtin_amdgcn_rcpf(wsf[32+crow(r,hi)]);
  bf16*Ow=Ou+(long)wid*QBLK*DM;
  { bf16*stg=(bf16*)(shm+LDS_OST)+wid*2048;
    #pragma unroll
    for(int hv=0;hv<2;++hv){
      #pragma unroll
      for(int r=0;r<16;++r){const int orow=crow(r,hi);
        #pragma unroll
        for(int d0=0;d0<2;++d0)stg[orow*64+d0*32+r32]=__float2bfloat16(o[2*hv+d0][r]*rli[r]);}
      asm volatile("s_waitcnt lgkmcnt(0)":::"memory");
      #pragma unroll
      for(int i=0;i<4;++i){const int row=i*8+(lane>>3),ch=lane&7; const u32x4 v=*(const u32x4*)(stg+row*64+ch*8); ATTN_STORE16(Ow+(long)row*DM+hv*64+ch*8,v);}
      asm volatile("s_waitcnt lgkmcnt(0)":::"memory");
    } }
  asm volatile("s_waitcnt lgkmcnt(0)\n\ts_barrier":::"memory");
  #undef DMA_K
  #undef DMA_V
  #undef CMASK
  #undef START
  #undef RESC
  #undef ROT
}
constexpr int ATTN_LDS_BYTES=LDS_BYTES;
#undef SBAR
#undef WAIT_BAR
}
#define GAS __attribute__((address_space(1)))
#define LAS __attribute__((address_space(3)))
typedef unsigned short bf16;
typedef unsigned v4u __attribute__((ext_vector_type(4)));
typedef float f32x4 __attribute__((ext_vector_type(4)));
typedef short bf16x8 __attribute__((ext_vector_type(8)));
typedef GAS unsigned gu32;
typedef GAS unsigned long long gu64;
#define RLX_AGENT __ATOMIC_RELAXED, __HIP_MEMORY_SCOPE_AGENT
#define LDS_WAIT() asm volatile("s_waitcnt lgkmcnt(0)" ::: "memory")
#define VM_WAIT() asm volatile("s_waitcnt vmcnt(0)" ::: "memory")
__device__ __forceinline__ unsigned long long rt() { return __builtin_amdgcn_s_memrealtime(); }
__device__ __forceinline__ unsigned f2bf(float f) { unsigned u = __builtin_bit_cast(unsigned, f); return (u + 0x7fffu + ((u >> 16) & 1u)) >> 16; }
__device__ __forceinline__ unsigned pk2(float lo, float hi) { return f2bf(lo) | (f2bf(hi) << 16); }

#define XB_TMO      128
#define XB_XCNT(j)  (256  + 64 * (j))
#define XB_XSUB(j)  (1280 + 64 * (j))
#define XB_XGEN(j)  (2304 + 64 * (j))
#define XB_TOP      3328
#define XB_TOPGEN   3392
#define XCD_BAR_WORDS 3456
#define XB_SPIN_CAP (1u << 18)

__device__ __forceinline__ unsigned xb_ld(unsigned* p)              { return __hip_atomic_load(p, __ATOMIC_RELAXED, __HIP_MEMORY_SCOPE_AGENT); }
__device__ __forceinline__ unsigned xb_add(unsigned* p, unsigned v) { return __hip_atomic_fetch_add(p, v, __ATOMIC_RELAXED, __HIP_MEMORY_SCOPE_AGENT); }
__device__ __forceinline__ unsigned xb_xcc_id() { return (unsigned)__builtin_amdgcn_s_getreg((3 << 11) | 20) & 0xFu; }
#define XB_SPIN(cond, bar) do { unsigned _sp = 0; while (cond) { __builtin_amdgcn_s_sleep(1); \
    if ((++_sp & 255u) == 0u) { if (xb_ld(&(bar)[XB_TMO])) break; if (_sp > XB_SPIN_CAP) { atomicAdd(&(bar)[XB_TMO], 1u); break; } } } } while (0)

struct XcdBarrier {
    unsigned* bar; unsigned x;
    volatile LAS unsigned* st;
};

__device__ __forceinline__ XcdBarrier xcd_barrier_post(unsigned* bar, volatile LAS unsigned* st) {
    XcdBarrier b; b.bar = bar; b.x = xb_xcc_id(); b.st = st;
    if (threadIdx.x == 0) (void)xb_add(&bar[XB_XCNT(b.x)], 1u);
    return b;
}
__device__ __forceinline__ void xcd_barrier_complete(unsigned* bar, unsigned x, unsigned& nloc, unsigned& nx) {
    const unsigned G = gridDim.x * gridDim.y * gridDim.z;
    unsigned sum, cnt, mine, sp = 0u;
    for (;;) {
        sum = 0u; cnt = 0u; mine = 0u;
#pragma unroll
        for (unsigned j = 0; j < 16; ++j) { const unsigned c = xb_ld(&bar[XB_XCNT(j)]); sum += c; cnt += (c > 0u) ? 1u : 0u; mine = (j == x) ? c : mine; }
        if (sum == G) break;
        __builtin_amdgcn_s_sleep(1);
        if ((++sp & 255u) == 0u) { if (xb_ld(&bar[XB_TMO])) break; if (sp > XB_SPIN_CAP) { atomicAdd(&bar[XB_TMO], 1u); break; } }
    }
    nloc = mine > 0u ? mine : 1u; nx = cnt > 0u ? cnt : 1u;
}

__device__ __forceinline__ void xcd_barrier(const XcdBarrier& b) {
    asm volatile("s_waitcnt vmcnt(0)" ::: "memory");
    __syncthreads();
    if (threadIdx.x == 0) {
        unsigned* bar = b.bar;
        __builtin_amdgcn_s_waitcnt(0);
        unsigned nloc = b.st[0], nx = b.st[1];
        if (nloc == 0u) { xcd_barrier_complete(bar, b.x, nloc, nx); b.st[0] = nloc; b.st[1] = nx; }
        const unsigned old = xb_add(&bar[XB_XSUB(b.x)], 1u);
        const unsigned gen = old / nloc;
        if (old + 1u == (gen + 1u) * nloc) {
            __builtin_amdgcn_fence(__ATOMIC_RELEASE, "agent");
            asm volatile("s_waitcnt vmcnt(0)" ::: "memory");
            const unsigned og = xb_add(&bar[XB_TOP], 1u);
            const unsigned tg = og / nx;
            if (og + 1u == (tg + 1u) * nx) xb_add(&bar[XB_TOPGEN], 1u);
            else XB_SPIN(xb_ld(&bar[XB_TOPGEN]) == tg, bar);
            __builtin_amdgcn_fence(__ATOMIC_ACQUIRE, "agent");
            xb_add(&bar[XB_XGEN(b.x)], 1u);
            asm volatile("s_waitcnt vmcnt(0)" ::: "memory");
        } else {
            XB_SPIN(xb_ld(&bar[XB_XGEN(b.x)]) == gen, bar);
            __builtin_amdgcn_fence(__ATOMIC_ACQUIRE, "agent");
            asm volatile("s_waitcnt vmcnt(0)" ::: "memory");
        }
    }
    __syncthreads();
}
#ifndef PROBE_SEL
#define PROBE_SEL -1
#endif
__device__ __forceinline__ float wave_sum(float v) {
#pragma unroll
    for (int o = 1; o < 64; o <<= 1) v += __shfl_xor(v, o);
    return v;
}
__device__ __forceinline__ void p0_transpose_item(const float* W, int K, int N, bf16* WT, LAS float* scr, int item, int lane) {
    const int nblk = N / 32, kb = item / nblk, nb = item % nblk, k0 = 64 * kb, n0 = 32 * nb;
    float rg[32];
    const float* wp = W + (size_t)(k0 + (lane >> 5)) * N + n0 + (lane & 31);
#pragma unroll
    for (int i = 0; i < 32; ++i) rg[i] = __builtin_nontemporal_load(wp + (size_t)(2 * i) * N);
#pragma unroll
    for (int i = 0; i < 32; ++i) scr[(2 * i + (lane >> 5)) * 33 + (lane & 31)] = rg[i];
    LDS_WAIT(); asm volatile("" ::: "memory");
    const int c = lane & 7;
#pragma unroll
    for (int j = 0; j < 4; ++j) { const int n = (lane >> 3) + 8 * j; const LAS float* s = scr + (8 * c) * 33 + n;
        v4u o; o.x = pk2(s[0 * 33], s[1 * 33]); o.y = pk2(s[2 * 33], s[3 * 33]); o.z = pk2(s[4 * 33], s[5 * 33]); o.w = pk2(s[6 * 33], s[7 * 33]);
        *(GAS v4u*)(WT + (size_t)(n0 + n) * K + k0 + 8 * c) = o; }
    LDS_WAIT(); asm volatile("" ::: "memory");
}
__device__ __forceinline__ void row_load(const float* xrow, int lane, f32x4 (&v)[8]) {
    const GAS f32x4* xr = (const GAS f32x4*)xrow + lane;
#pragma unroll
    for (int j = 0; j < 8; ++j) v[j] = xr[64 * j];
}
__device__ __forceinline__ void row_load_nt(const float* xrow, int lane, f32x4 (&v)[8]) {
    const f32x4* xr = (const f32x4*)xrow + lane;
#pragma unroll
    for (int j = 0; j < 8; ++j) v[j] = __builtin_nontemporal_load(xr + 64 * j);
}
__device__ __forceinline__ float row_rstd(const f32x4 (&v)[8]) {
    float s = 0.f;
#pragma unroll
    for (int j = 0; j < 8; ++j) s += (v[j].x * v[j].x + v[j].y * v[j].y) + (v[j].z * v[j].z + v[j].w * v[j].w);
    return 1.f / sqrtf(wave_sum(s) * (1.f / DM_) + EPS_);
}
__device__ __forceinline__ void norm_mod_store(const f32x4 (&v)[8], const float* g, const float* sh, const float* sc, bf16* orow, int lane) {
    const float rstd = row_rstd(v);
    GAS unsigned long long* o8 = (GAS unsigned long long*)orow + lane;
#pragma unroll
    for (int j = 0; j < 8; ++j) { const f32x4 gg = ((const GAS f32x4*)g)[64 * j + lane], hh = ((const GAS f32x4*)sh)[64 * j + lane], cc = ((const GAS f32x4*)sc)[64 * j + lane];
        const f32x4 y = v[j] * rstd * gg * (cc + 1.0f) + hh;
        o8[64 * j] = (unsigned long long)pk2(y.x, y.y) | ((unsigned long long)pk2(y.z, y.w) << 32); }
}
#define ROW_PIPE(m0, step, M, LOAD, BODY) ROW_PIPE_N(8, m0, step, M, LOAD, BODY)
#define ROW_PIPE_N(NB, m0, step, M, LOAD, BODY) do { int m_ = (m0); f32x4 va_[NB], vb_[NB]; if (m_ < (M)) { LOAD(va_, m_); } \
    while (m_ < (M)) { const int m1_ = m_ + (step); if (m1_ < (M)) { LOAD(vb_, m1_); } BODY(va_, m_); if (m1_ >= (M)) break; \
        const int m2_ = m1_ + (step); if (m2_ < (M)) { LOAD(va_, m2_); } BODY(vb_, m1_); m_ = m2_; } } while (0)

template <int MODE> struct EpiResNorm {
    static constexpr bool PERM = false;
    const float* base; float* out; const float* gate; float* rowsq; const float* gvec; const float* mod_sc; const float* mod_sh; bf16* xn; XcdBarrier bar; float probe_delta;
    __device__ __forceinline__ bool operator()(pg8::f32x4 (&acc)[2][2][4][2], const pg8::Unit& u_, int wr, int wc, int fr, int fq) const {
        pg8::Unit u; u.pm = u_.pm; u.pn = u_.pn; u.z = u_.z; asm volatile("" : "+s"(u.pm), "+s"(u.pn), "+s"(u.z));
        const int b = u.pm >> 4, col0 = u.pn * 256 + wc * 32 + 4 * fq;
        { f32x4 gv[2][2];
#pragma unroll
          for (int bj = 0; bj < 2; ++bj)
#pragma unroll
              for (int n = 0; n < 2; ++n) gv[bj][n] = *(const f32x4*)(gate + (size_t)b * NMOD + col0 + bj * 128 + n * 16);
#pragma unroll
          for (int ai = 0; ai < 2; ++ai)
#pragma unroll
              for (int mp = 0; mp < 2; ++mp) {
                  f32x4 bs[2][2][2];
#pragma unroll
                  for (int mm = 0; mm < 2; ++mm) { const size_t off = (size_t)(u.pm * 256 + ai * 128 + wr * 64 + (2 * mp + mm) * 16 + fr) * DM_ + col0;
#pragma unroll
                      for (int bj = 0; bj < 2; ++bj)
#pragma unroll
                          for (int n = 0; n < 2; ++n) bs[mm][bj][n] = __builtin_nontemporal_load((const f32x4*)(base + off + bj * 128 + n * 16)); }
                  asm volatile("" ::: "memory");
#pragma unroll
                  for (int mm = 0; mm < 2; ++mm) { const int m = 2 * mp + mm; const int row = u.pm * 256 + ai * 128 + wr * 64 + m * 16 + fr; float s = 0.f;
#pragma unroll
                      for (int bj = 0; bj < 2; ++bj)
#pragma unroll
                          for (int n = 0; n < 2; ++n) { const f32x4 y = bs[mm][bj][n] + gv[bj][n] * acc[ai][bj][m][n]; acc[ai][bj][m][n] = y; s += (y.x * y.x + y.y * y.y) + (y.z * y.z + y.w * y.w); }
                      s += __shfl_xor(s, 16); s += __shfl_xor(s, 32);
                      if (fq == 0) atomicAdd(rowsq + row, s); }
                  asm volatile("" ::: "memory"); } }
        xcd_barrier(bar);
        f32x4 Av[2][2], Bv[2][2];
#pragma unroll
        for (int bj = 0; bj < 2; ++bj)
#pragma unroll
            for (int n = 0; n < 2; ++n) { const int c = col0 + bj * 128 + n * 16; Av[bj][n] = *(const f32x4*)(gvec + c);
                if (MODE == 0) { Av[bj][n] = Av[bj][n] * (*(const f32x4*)(mod_sc + (size_t)b * NMOD + c) + 1.0f); Bv[bj][n] = *(const f32x4*)(mod_sh + (size_t)b * NMOD + c); } }
#pragma unroll
        for (int ai = 0; ai < 2; ++ai)
#pragma unroll
            for (int m = 0; m < 4; ++m) { const int row = u.pm * 256 + ai * 128 + wr * 64 + m * 16 + fr; const size_t off = (size_t)row * DM_ + col0;
                const float rstd = 1.f / sqrtf(__hip_atomic_load(rowsq + row, __ATOMIC_RELAXED, __HIP_MEMORY_SCOPE_AGENT) * (1.f / DM_) + EPS_);
#pragma unroll
                for (int bj = 0; bj < 2; ++bj)
#pragma unroll
                    for (int n = 0; n < 2; ++n) { const f32x4 y = acc[ai][bj][m][n];
                        if (MODE == 0) { __builtin_nontemporal_store(y, (f32x4*)(out + off + bj * 128 + n * 16)); const f32x4 h = y * rstd * Av[bj][n] + Bv[bj][n];
                            *(unsigned long long*)(xn + off + bj * 128 + n * 16) = (unsigned long long)pk2(h.x, h.y) | ((unsigned long long)pk2(h.z, h.w) << 32); }
                        else { f32x4 o = y * rstd * Av[bj][n]; if (PROBE_SEL >= 0 && blockIdx.x == 0) o = o + probe_delta; __builtin_nontemporal_store(o, (f32x4*)(out + off + bj * 128 + n * 16)); } } }
        return false;
    }
};

struct Args { const float* in[20]; float* out; unsigned char* ws; int ph_lo, ph_hi, li, coop; };
__global__ void __launch_bounds__(NWAVES * 64, 2) mk_fwd(Args args) {
    extern __shared__ __attribute__((aligned(16))) unsigned char lds[];
    LAS unsigned char* const ldsp = (LAS unsigned char*)lds;
    volatile LAS unsigned* MISC = (volatile LAS unsigned*)(ldsp + MISC_OFF);
    const int tid = threadIdx.x, lane = tid & 63, wave = __builtin_amdgcn_readfirstlane(tid >> 6);
    const int G = gridDim.x, bx = blockIdx.x; const int vcu = (G % 8 == 0) ? (bx % 8) * (G / 8) + bx / 8 : bx;
    unsigned char* ws = args.ws;
    gu32* ctl = (gu32*)(ws + WS_CTL);
    const float *x = args.in[0], *cvec = args.in[1], *ctxp = args.in[2], *c_ctx = args.in[3], *w_ada = args.in[4], *b_ada = args.in[5], *g_norm1 = args.in[6], *w_in = args.in[7],
                *lam_q1 = args.in[8], *lam_k1 = args.in[9], *lam_q2 = args.in[10], *lam_k2 = args.in[11], *g_subln = args.in[12], *w_attn_br = args.in[13], *w_four_br = args.in[14],
                *w_out = args.in[15], *g_norm2 = args.in[16], *w_mlp_in = args.in[17], *w_mlp_out = args.in[18], *g_final = args.in[19];
    float* out = args.out;
    float* MOD = (float*)(ws + WS_MOD);
    for (int u = tid; u < (LDS_BYTES - LDSCTL_OFF) / 4; u += NWAVES * 64) ((LAS unsigned*)(ldsp + LDSCTL_OFF))[u] = 0u;
    __syncthreads();
    XcdBarrier bar = xcd_barrier_post((unsigned*)(ctl + CW_BAR) + args.li * XCD_BAR_WORDS, MISC + 8);
    const int lo = args.ph_lo, hi = args.ph_hi;
    if (PROBE_SEL >= 0 && bx == 0 && tid == 0) MISC[16] = (unsigned)__builtin_amdgcn_s_memrealtime();
    if (PROBE_SEL >= 30 && tid == 0) ((unsigned*)(ws + 8192))[bx] = (unsigned)__builtin_amdgcn_s_memrealtime();
#ifndef PHMASK
#define PHMASK 0xfff
#endif
#define IN(k) ((((PHMASK) >> (k)) & 1) && lo <= (k) && (k) < hi)
#define STAMP(k) do { if (PROBE_SEL >= 0 && bx == 0 && tid == 0) MISC[16 + (k)] = (unsigned)__builtin_amdgcn_s_memrealtime(); } while (0)
#define SEAM(k) do { if (IN(k) && IN((k) + 1)) xcd_barrier(bar); STAMP((k) + 1); } while (0)
    const int gw = bx * NWAVES + wave, NGW = G * NWAVES, gt = bx * (NWAVES * 64) + tid, NGT = G * NWAVES * 64;

    if (IN(0)) {
        LAS float* scr = (LAS float*)(ldsp + RING_OFF + wave * 16384);
        constexpr int I_IN = (DM_ / 64) * (INCOLS / 32), I_AT = (1024 / 64) * (DM_ / 32), I_OUT = (DM_ / 64) * (DM_ / 32);
        constexpr int NITEMS = I_IN + 2 * I_AT + I_OUT;
        for (int it = gw; it < NITEMS; it += NGW) {
            int r = it;
            if (r < I_IN) { p0_transpose_item(w_in, DM_, INCOLS, (bf16*)(ws + WS_WIN), scr, r, lane); continue; } r -= I_IN;
            if (r < I_AT) { p0_transpose_item(w_attn_br, 1024, DM_, (bf16*)(ws + WS_WATT), scr, r, lane); continue; } r -= I_AT;
            if (r < I_AT) { p0_transpose_item(w_four_br, 1024, DM_, (bf16*)(ws + WS_WFOUR), scr, r, lane); continue; } r -= I_AT;
            p0_transpose_item(w_out, DM_, DM_, (bf16*)(ws + WS_WOUT), scr, r, lane);
        }
        { bf16* D = (bf16*)(ws + WS_DFTM);
          STAMP(14);
          LAS float* tab = (LAS float*)(ldsp + RING_OFF);
          __syncthreads();
          for (int j = tid; j < 4096; j += NWAVES * 64) tab[j] = cospif((float)j * (1.0f / 2048.0f));
          __syncthreads();
          for (int idx = gt; idx < 2048 * (FKP / 8); idx += NGT) {     const int lp = idx / (FKP / 8), c8 = (idx - lp * (FKP / 8)) * 8; float cv[8];
              const bool sn = c8 >= FKC; const int kb = sn ? c8 - FKC : c8;
#pragma unroll
              for (int e = 0; e < 8; ++e) { const int j = (lp * (kb + e)) & 4095; cv[e] = tab[sn ? ((j - 1024) & 4095) : j]; }
              v4u oc; oc.x = pk2(cv[0], cv[1]); oc.y = pk2(cv[2], cv[3]); oc.z = pk2(cv[4], cv[5]); oc.w = pk2(cv[6], cv[7]);
              *(GAS v4u*)(D + (size_t)lp * FKP + c8) = oc; } }
        STAMP(15);
        { bf16* CS = (bf16*)(ws + WS_CS);
          for (int idx = gt; idx < 512 * 256; idx += NGT) { const int mrow = idx >> 8, cc = idx & 255, n = mrow & 255; const float xx = (float)((n * cc) & 255) * (1.0f / 128.0f);
              CS[idx] = (bf16)f2bf((mrow >> 8) ? sinpif(xx) : cospif(xx)); } }
        { float* rc = (float*)(ws + WS_ROPEC); float* rs = (float*)(ws + WS_ROPES);
          for (int idx = gt; idx < 1024; idx += NGT) { const int pos = idx >> 4, j = idx & 15; const float inv = powf(10000.0f, -(float)(2 * j) / 32.0f); const float ang = (float)pos * inv; rc[idx] = cosf(ang); rs[idx] = sinf(ang); } }
        { LAS float* sil = (LAS float*)(ldsp + RING_OFF);
          LAS float* red = (LAS float*)(ldsp + RING_OFF + 24576);
          __syncthreads();
          for (int q = tid; q < 3 * 2048; q += NWAVES * 64) { const float v = q < 4096 ? cvec[q] : c_ctx[q - 4096]; sil[q] = v / (1.f + __expf(-v)); }
          __syncthreads();
          for (int blk = bx; blk < 192; blk += G) {
              const int ks = tid >> 4, cq = tid & 15, kbase = ks * 64;
              f32x4 a0 = {0.f, 0.f, 0.f, 0.f}, a1 = a0, a2 = a0;
              const float* wp = w_ada + (size_t)kbase * NMOD + blk * 64 + cq * 4;
#pragma unroll 16
              for (int kk = 0; kk < 64; ++kk) { const f32x4 w = __builtin_nontemporal_load((const f32x4*)(wp + (size_t)kk * NMOD));
                  a0 += w * sil[kbase + kk]; a1 += w * sil[2048 + kbase + kk]; a2 += w * sil[4096 + kbase + kk]; }
              LAS float* rp = red + (ks * 16 + cq) * 12;
#pragma unroll
              for (int e = 0; e < 4; ++e) { rp[e] = a0[e]; rp[4 + e] = a1[e]; rp[8 + e] = a2[e]; }
              __syncthreads();
              if (tid < 192) { float s = 0.f;
#pragma unroll
                  for (int q = 0; q < 32; ++q) s += red[q * 192 + tid];
                  const int cq2 = tid / 12, comp = tid % 12, col = blk * 64 + cq2 * 4 + (comp & 3);
                  MOD[(comp >> 2) * NMOD + col] = s + b_ada[col]; }
              __syncthreads();
          } }
        STAMP(12);
        if (PROBE_SEL >= 20 && PROBE_SEL < 30 && tid == 0) ((unsigned*)(ws + 8192))[bx] = (unsigned)__builtin_amdgcn_s_memrealtime();
        if (IN(1)) { if (args.coop) cg::this_grid().sync(); else xcd_barrier(bar); }
        STAMP(1);
    }
    if (IN(1)) {
        bf16* XN = (bf16*)(ws + WS_XN);
#define P1_LOAD(buf, m) row_load_nt((m) < MTOK ? x + (size_t)(m) * DM_ : ctxp + (size_t)((m) - MTOK) * DM_, lane, buf)
#define P1_BODY(buf, m) do { const float* md = MOD + (size_t)((m) < MTOK ? ((m) >> 12) : 2) * NMOD; norm_mod_store(buf, g_norm1, md, md + DM_, XN + (size_t)(m) * DM_, lane); } while (0)
        {
          const int b = gw & 1; const float* md = MOD + (size_t)b * NMOD; f32x4 Av[8], Bv[8];
#pragma unroll
          for (int j = 0; j < 8; ++j) { Av[j] = ((const GAS f32x4*)g_norm1)[64 * j + lane] * (((const GAS f32x4*)(md + DM_))[64 * j + lane] + 1.0f); Bv[j] = ((const GAS f32x4*)md)[64 * j + lane]; }
#define P1L_LOAD(buf, r) row_load_nt(x + ((size_t)(b * SEQ_ + (r))) * DM_, lane, buf)
#define P1L_BODY(buf, r) do { const float rstd = row_rstd(buf); GAS unsigned long long* o8 = (GAS unsigned long long*)(XN + ((size_t)(b * SEQ_ + (r))) * DM_) + lane; \
            _Pragma("unroll") for (int j = 0; j < 8; ++j) { const f32x4 y = buf[j] * rstd * Av[j] + Bv[j]; o8[64 * j] = (unsigned long long)pk2(y.x, y.y) | ((unsigned long long)pk2(y.z, y.w) << 32); } } while (0)
          ROW_PIPE(gw >> 1, NGW >> 1, SEQ_, P1L_LOAD, P1L_BODY); }
        ROW_PIPE(MTOK + gw, NGW, MTOK + MCTX, P1_LOAD, P1_BODY);
        SEAM(1);
    }
    if (IN(2)) {
        pg8::Gemm g{ws, DM_, DM_, DM_}; pg8::SchedG1 S; S.mp.init(32, 32); S.G = G; S.c = bx; S.offA = WS_XN; S.offB = WS_WIN;
        pg8::EpiG1 E{ws, (const float*)(ws + WS_ROPEC), (const float*)(ws + WS_ROPES)};
        pg8::gemm_phase<pg8::EpiG1, pg8::SchedG1, true, true>(ldsp + RING_OFF, g, S, E);
        SEAM(2);
    }
    if (IN(3)) {
        { const bf16* Fb = (const bf16*)(ws + WS_F); bf16* FE = (bf16*)(ws + WS_FE); bf16* FO = (bf16*)(ws + WS_FO);
          for (int t = gt; t < 2 * 2304 * 128; t += NGT) { const int c8 = (t & 127) * 8, rk = t >> 7, b = rk / 2304, kk = rk - b * 2304;
              f32x4 a0 = {0.f, 0.f, 0.f, 0.f}, a1 = a0, c0 = a0, c1 = a0;
              if (kk <= 2048) pg8::unpack8(__builtin_nontemporal_load((const v4u*)(Fb + ((size_t)(b * 4096 + kk)) * 1024 + c8)), a0, a1);
              if (kk >= 1 && kk < 2048) pg8::unpack8(__builtin_nontemporal_load((const v4u*)(Fb + ((size_t)(b * 4096 + 4096 - kk)) * 1024 + c8)), c0, c1);
              *(GAS v4u*)(FE + ((size_t)(b * 2304 + kk)) * 1024 + c8) = pg8::pack8(a0 + c0, a1 + c1);
              if (kk < 2048) { if (kk == 0) { a0 = c0; a1 = c1; } *(GAS v4u*)(FO + ((size_t)(b * 2048 + kk)) * 1024 + c8) = pg8::pack8(a0 - c0, a1 - c1); } } }
        xcd_barrier(bar);
        pg8::Gemm g{ws, 256, 1024, 256}; pg8::SchedF1 S{G, bx, WS_CS, WS_FE, WS_FO};
        pg8::EpiF1 E{(bf16*)(ws + WS_TT)};
        pg8::gemm_phase<pg8::EpiF1, pg8::SchedF1, true, true>(ldsp + RING_OFF, g, S, E);
        const int rfirst = (G > 136) ? 136 : 0;
        if (bx >= rfirst)
        for (int t = (bx - rfirst) * (NWAVES * 64) + tid; t < 512 * 256; t += (G - rfirst) * (NWAVES * 64)) { const int j = t >> 8, c8 = (t & 255) * 8; const float* P = (const float*)(ws + WS_PART) + (size_t)j * 2048 + c8;
            f32x4 s0 = *(const GAS f32x4*)P, s1 = *(const GAS f32x4*)(P + 4);
#pragma unroll
            for (int q = 1; q < 8; ++q) { s0 += *(const GAS f32x4*)(P + (size_t)q * (512 * 2048)); s1 += *(const GAS f32x4*)(P + (size_t)q * (512 * 2048) + 4); }
            bf16* dst = (bf16*)(ws + WS_K + (size_t)(c8 >> 10) * (WS_V - WS_K)) + (size_t)((j >> 8) * 4352 + 4096 + (j & 255)) * 1024 + (c8 & 1023);
            *(GAS v4u*)dst = pg8::pack8(s0, s1); }
        SEAM(3);
    }
    if (IN(4)) {
        const attn_body::bf16 *Qb = (const attn_body::bf16*)(ws + WS_Q), *Kb = (const attn_body::bf16*)(ws + WS_K), *Vb = (const attn_body::bf16*)(ws + WS_V);
        for (int i = 0; ; ++i) { const int L = i * G + vcu; if (L >= 512) break;
            const int prob = (L & 255) >> 3, qb = ((L >> 8) << 3) | (L & 7), b = prob >> 4, h = (prob >> 1) & 7, c = prob & 1;
            attn_body::bf16* Ob = (attn_body::bf16*)(ws + WS_O0 + (size_t)c * (WS_O1 - WS_O0));
            attn_body::attn_unit<8>(Qb + ((size_t)(b * SEQ_ + qb * 256)) * 1024 + (h * 2 + c) * 64, Kb + (size_t)b * 4352 * 1024 + (h * 2 + c) * 64, Vb + (size_t)b * 4352 * 1024 + h * 128,
                                    Ob + ((size_t)(b * SEQ_ + qb * 256)) * 1024 + h * 128, (char*)lds + RING_OFF);
        }
        asm volatile("s_waitcnt vmcnt(0) lgkmcnt(0)" ::: "memory"); __syncthreads();
        STAMP(13);
        for (int w2 = gw; w2 < 2048; w2 += NGW) { const int b = w2 >> 10, ch = w2 & 1023; const bf16* row = (const bf16*)(ws + WS_TT) + ((size_t)((b * 4 + (ch >> 8)) * 256 + (ch & 255))) * FKP;
            float s = 0.f;
#pragma unroll
            for (int q = 0; q < 4; ++q) { f32x4 e0, e1; pg8::unpack8(*(const GAS v4u*)(row + lane * 32 + q * 8), e0, e1); s += (e0.x - e0.y) + (e0.z - e0.w) + (e1.x - e1.y) + (e1.z - e1.w); }
            s = wave_sum(s) + __uint_as_float((unsigned)row[2048] << 16);
            if (lane == 0) ((float*)(ws + WS_Y2048))[w2] = s; }
        pg8::Gemm g{ws, FKP, FKP, FKP}; pg8::SchedF2 S{G, bx, WS_DFTM, WS_TT};
        pg8::EpiF2 E{(bf16*)(ws + WS_YC)};
        pg8::gemm_phase<pg8::EpiF2, pg8::SchedF2, true, true>(ldsp + RING_OFF, g, S, E);
        SEAM(4);
    }
    if (IN(5)) {
        const float lam = __expf(wave_sum(lam_q1[lane] * lam_k1[lane])) - __expf(wave_sum(lam_q2[lane] * lam_k2[lane])) + LAM_INIT;
        const bf16 *O0 = (const bf16*)(ws + WS_O0), *O1 = (const bf16*)(ws + WS_O1); bf16 *AA = (bf16*)(ws + WS_AATT), *YB = (bf16*)(ws + WS_YB);
        const bf16* Yp = (const bf16*)(ws + WS_YC); const float* Y2048 = (const float*)(ws + WS_Y2048);
        f32x4 gs[4];
#pragma unroll
        for (int j = 0; j < 4; ++j) gs[j] = ((const GAS f32x4*)g_subln)[(lane & 7) * 4 + j] * (1.0f - LAM_INIT);
#define P5_LOAD(buf, m) do { const size_t off_ = (size_t)(m) * 1024 + lane * 16; \
            buf[0] = __builtin_nontemporal_load((const f32x4*)(O0 + off_)); buf[1] = __builtin_nontemporal_load((const f32x4*)(O0 + off_ + 8)); buf[2] = __builtin_nontemporal_load((const f32x4*)(O1 + off_)); buf[3] = __builtin_nontemporal_load((const f32x4*)(O1 + off_ + 8)); \
            const int lq_ = (m) & 4095, ls_ = lq_ < 2048 ? lq_ : (lq_ == 2048 ? 0 : 4096 - lq_); const size_t yo_ = ((size_t)(((m) >> 12) * 2048 + ls_)) * 1024 + lane * 16; \
            _Pragma("unroll") for (int p_ = 0; p_ < 4; ++p_) { buf[4 + 2 * p_] = __builtin_nontemporal_load((const f32x4*)(Yp + (size_t)p_ * (4096 * 1024) + yo_)); buf[5 + 2 * p_] = __builtin_nontemporal_load((const f32x4*)(Yp + (size_t)p_ * (4096 * 1024) + yo_ + 8)); } } while (0)
#define P5_BODY(buf, m) do { const size_t off = (size_t)(m) * 1024 + lane * 16; \
            f32x4 o[4], p[4]; pg8::unpack8(__builtin_bit_cast(v4u, buf[0]), o[0], o[1]); pg8::unpack8(__builtin_bit_cast(v4u, buf[1]), o[2], o[3]); \
            pg8::unpack8(__builtin_bit_cast(v4u, buf[2]), p[0], p[1]); pg8::unpack8(__builtin_bit_cast(v4u, buf[3]), p[2], p[3]); \
            float ss = 0.f; \
            _Pragma("unroll") for (int j = 0; j < 4; ++j) { o[j] = o[j] - p[j] * lam; ss += (o[j].x * o[j].x + o[j].y * o[j].y) + (o[j].z * o[j].z + o[j].w * o[j].w); } \
            ss += __shfl_xor(ss, 1); ss += __shfl_xor(ss, 2); ss += __shfl_xor(ss, 4); \
            const float r = 1.f / sqrtf(ss * (1.f / 128.f) + EPS_); \
            _Pragma("unroll") for (int j = 0; j < 4; ++j) o[j] = o[j] * r * gs[j]; \
            *(GAS v4u*)(AA + off) = pg8::pack8(o[0], o[1]); *(GAS v4u*)(AA + off + 8) = pg8::pack8(o[2], o[3]); \
            f32x4 y[4], q[4], t[4]; const int lq = (m) & 4095; const float sg = lq < 2048 ? -1.0f : 1.0f;     \
            pg8::unpack8(__builtin_bit_cast(v4u, buf[4]), y[0], y[1]); pg8::unpack8(__builtin_bit_cast(v4u, buf[5]), y[2], y[3]); pg8::unpack8(__builtin_bit_cast(v4u, buf[6]), t[0], t[1]); pg8::unpack8(__builtin_bit_cast(v4u, buf[7]), t[2], t[3]); \
            _Pragma("unroll") for (int j = 0; j < 4; ++j) y[j] = y[j] + t[j]; \
            pg8::unpack8(__builtin_bit_cast(v4u, buf[8]), q[0], q[1]); pg8::unpack8(__builtin_bit_cast(v4u, buf[9]), q[2], q[3]); pg8::unpack8(__builtin_bit_cast(v4u, buf[10]), t[0], t[1]); pg8::unpack8(__builtin_bit_cast(v4u, buf[11]), t[2], t[3]); \
            _Pragma("unroll") for (int j = 0; j < 4; ++j) y[j] = (y[j] + sg * (q[j] + t[j])) * (1.0f / 1024.0f); \
            if (lq == 2048) { _Pragma("unroll") for (int j = 0; j < 4; ++j) y[j] = *(const GAS f32x4*)(Y2048 + ((m) >> 12) * 1024 + lane * 16 + 4 * j) * (1.0f / 1024.0f); } \
            *(GAS v4u*)(YB + off) = pg8::pack8(y[0], y[1]); *(GAS v4u*)(YB + off + 8) = pg8::pack8(y[2], y[3]); } while (0)
        ROW_PIPE_N(12, gw, NGW, MTOK, P5_LOAD, P5_BODY);
        {
          LAS float* scr = (LAS float*)(ldsp + RING_OFF + wave * 16384);
          constexpr int I_1 = (DM_ / 64) * (DFF / 32), I_2 = (DFF / 64) * (DM_ / 32);
          for (int it = gw; it < I_1 + I_2; it += NGW) {
              if (it < I_1) p0_transpose_item(w_mlp_in, DM_, DFF, (bf16*)(ws + WS_WIN), scr, it, lane);
              else p0_transpose_item(w_mlp_out, DFF, DM_, (bf16*)(ws + WS_TT), scr, it - I_1, lane);
          } }
        SEAM(5);
    }
    if (IN(6)) {
        pg8::Gemm g{ws, 1024, 1024, 1024}; pg8::SchedMerged S; S.mp.init(32, 8); S.G = G; S.c = bx; S.offA0 = WS_AATT; S.offB0 = WS_WATT; S.offA1 = WS_YB; S.offB1 = WS_WFOUR;
        pg8::EpiMerged E{(const bf16*)(ws + WS_SGA), (const bf16*)(ws + WS_SGF), (bf16*)(ws + WS_MB)};
        pg8::gemm_phase<pg8::EpiMerged, pg8::SchedMerged, true, true>(ldsp + RING_OFF, g, S, E);
        SEAM(6);
    }
    if (IN(7)) {
        pg8::Gemm g{ws, DM_, DM_, DM_}; pg8::SchedTiles S; S.mp.init(32, 8); S.G = G; S.c = bx; S.nt = DM_ / 64; S.offA = WS_MB; S.offB = WS_WOUT; S.tA = (size_t)256 * DM_ * 2; S.tB = (size_t)256 * DM_ * 2;
        EpiResNorm<0> E{x, (float*)(ws + WS_XMID), MOD + 2 * DM_, (float*)(ws + WS_ROWSQ1), g_norm2, MOD + 4 * DM_, MOD + 3 * DM_, (bf16*)(ws + WS_XN), bar, 0.f};
        pg8::gemm_phase<EpiResNorm<0>, pg8::SchedTiles, true, true>(ldsp + RING_OFF, g, S, E);
        SEAM(7);
    }
    STAMP(9);
    if (IN(9)) {
        pg8::Gemm g{ws, DM_, DM_, DM_}; pg8::SchedTiles S; S.mp.init(32, 32); S.G = G; S.c = bx; S.nt = DM_ / 64; S.offA = WS_XN; S.offB = WS_WIN; S.tA = (size_t)256 * DM_ * 2; S.tB = (size_t)256 * DM_ * 2;
        pg8::EpiRelu2 E{(bf16*)(ws + WS_Z)};
        pg8::gemm_phase<pg8::EpiRelu2, pg8::SchedTiles, true, true>(ldsp + RING_OFF, g, S, E);
        SEAM(9);
    }
    if (IN(10)) {
        float probe_delta = 0.f;
        if (PROBE_SEL >= 0 && bx == 0) { float T_us;
            if (PROBE_SEL < 20) T_us = (float)(MISC[16 + (PROBE_SEL >= 0 && PROBE_SEL < 16 ? PROBE_SEL : 0)] - MISC[16]) * 0.01f;
            else { const unsigned* st = (const unsigned*)(ws + 8192); const unsigned t0 = MISC[16]; unsigned mx = 0, amx = 0, mn = 0xffffffffu, cnt = 0;
                for (int q = 0; q < G; ++q) { const unsigned d = st[q] - t0; if (d > mx) { mx = d; amx = q; } if (d < mn) mn = d; if (d > 6000u) ++cnt; }
                T_us = PROBE_SEL == 20 ? mx * 0.01f : PROBE_SEL == 21 ? (float)amx : PROBE_SEL == 22 ? mn * 0.01f : (float)cnt; }
            probe_delta = sqrtf(T_us * 2.56e-6f); }
        pg8::Gemm g{ws, DFF, DFF, DFF}; pg8::SchedTiles S; S.mp.init(32, 8); S.G = G; S.c = bx; S.nt = DFF / 64; S.offA = WS_Z; S.offB = WS_TT; S.tA = (size_t)256 * DFF * 2; S.tB = (size_t)256 * DFF * 2;
        EpiResNorm<1> E{(const float*)(ws + WS_XMID), out, MOD + 5 * DM_, (float*)(ws + WS_ROWSQ2), g_final, nullptr, nullptr, nullptr, bar, probe_delta};
        pg8::gemm_phase<EpiResNorm<1>, pg8::SchedTiles, true, true>(ldsp + RING_OFF, g, S, E);
    }
#undef IN
#undef SEAM
}

constexpr int NPHASE = 12;
extern "C" void kernel_launch(void* const* d_in, const int* in_sizes, int n_in, void* d_out, int out_size, void* d_ws, size_t ws_size, hipStream_t stream) {
    static int grid = 0;
    if (grid == 0) {
        if (n_in != 20 || in_sizes[0] != MTOK * DM_ || out_size != MTOK * DM_ || ws_size < WS_END) { fprintf(stderr, "kernel_launch: unexpected shapes / workspace (n_in %d, in0 %d, out %d, ws %zu, need %zu)\n", n_in, n_in > 0 ? in_sizes[0] : -1, out_size, ws_size, (size_t)WS_END); grid = -1; return; }
        int dev = 0, cus = 0, per_cu = 0;
        if (hipGetDevice(&dev) != hipSuccess || hipDeviceGetAttribute(&cus, hipDeviceAttributeMultiprocessorCount, dev) != hipSuccess) { fprintf(stderr, "kernel_launch: device query failed\n"); grid = -1; return; }
        if (hipFuncSetAttribute((const void*)mk_fwd, hipFuncAttributeMaxDynamicSharedMemorySize, LDS_BYTES) != hipSuccess) { fprintf(stderr, "kernel_launch: hipFuncSetAttribute failed\n"); grid = -1; return; }
        if (hipOccupancyMaxActiveBlocksPerMultiprocessor(&per_cu, (const void*)mk_fwd, NWAVES * 64, LDS_BYTES) != hipSuccess || per_cu < 1) { fprintf(stderr, "kernel_launch: occupancy query says %d blocks per CU\n", per_cu); per_cu = 1; }
        (void)hipGetLastError();
        grid = cus;
        if (cus != 256) { fprintf(stderr, "kernel_launch: built for a 256-CU device (one 256x256 tile per workgroup in the fused-norm GEMM phases); found %d CUs\n", cus); grid = -1; return; }
    }
    if (grid < 0) return;
    if (hipMemsetAsync((char*)d_ws + WS_CTL, 0, CTL_ZERO_BYTES, stream) != hipSuccess) { fprintf(stderr, "kernel_launch: memset failed\n"); return; }
    Args a{};
    for (int i = 0; i < 20; ++i) a.in[i] = (const float*)d_in[i];
    a.out = (float*)d_out; a.ws = (unsigned char*)d_ws; a.ph_lo = 0; a.ph_hi = NPHASE; a.li = 0; a.coop = 0;
    void* kargs[] = {&a};
    const hipError_t le = hipLaunchCooperativeKernel((const void*)mk_fwd, dim3(grid), dim3(NWAVES * 64), kargs, LDS_BYTES, stream);
    if (le != hipSuccess) fprintf(stderr, "kernel_launch: cooperative launch failed: %s (grid %d)\n", hipGetErrorString(le), grid);
}
```

```cpp
#include <hip/hip_cooperative_groups.h>
namespace cg = cooperative_groups;
#include <cstddef>
constexpr int NWAVES = 8;
constexpr int DM_ = 2048, SEQ_ = 4096, BATCH_ = 2, CTXL = 256, MTOK = BATCH_ * SEQ_  , MCTX = BATCH_ * CTXL  , INCOLS = 8192, DFF = 8192, NMOD = 6 * DM_  ;
constexpr float EPS_ = 1e-6f, LAM_INIT = 0.2f;
constexpr size_t MiB = 1u << 20;
constexpr size_t WS_CTL = 0, CTL_ZERO_BYTES = 1 * MiB;
constexpr size_t WS_MOD = 256 * 1024;
constexpr size_t WS_ROWSQ1 = 512 * 1024, WS_ROWSQ2 = 576 * 1024;
constexpr size_t WS_Y2048 = 1 * MiB + 384 * 1024;
constexpr size_t WS_YC = 50 * MiB, WS_YS = 66 * MiB;
constexpr size_t WS_MB = 84 * MiB;
constexpr size_t WS_XMID = 310 * MiB;
constexpr size_t WS_ROPEC = 1 * MiB, WS_ROPES = 1 * MiB + 4096, WS_CS = 1 * MiB + 65536;
constexpr size_t WS_WATT = 2 * MiB, WS_WFOUR = 6 * MiB, WS_WOUT = 10 * MiB;
constexpr size_t WS_WIN = 18 * MiB;
constexpr size_t WS_XN = 50 * MiB;
constexpr size_t WS_DFTM = 84 * MiB;
constexpr size_t WS_Q = 148 * MiB, WS_K = 164 * MiB, WS_V = 181 * MiB, WS_F = 198 * MiB, WS_SGA = 214 * MiB, WS_SGF = 246 * MiB;
constexpr size_t WS_AATT = WS_Q, WS_YB = WS_K, WS_Z = WS_Q;
constexpr size_t WS_TT = 278 * MiB;
constexpr size_t WS_O0 = 310 * MiB, WS_O1 = 326 * MiB;
constexpr size_t WS_FE = WS_O0, WS_FO = WS_O1;
constexpr int FKC = 2176, FKS = 2048, FKP = FKC + FKS;
constexpr size_t WS_PART = 342 * MiB, WS_END = 374 * MiB;
constexpr int CW_BAR = 4096;
constexpr int RING_OFF = 0, RING_BYTES = 131072;
constexpr int LDSCTL_OFF = RING_BYTES, MISC_OFF = LDSCTL_OFF + 320;
constexpr int LDS_BYTES = 147456;
static_assert(MISC_OFF + 128 <= LDS_BYTES, "LDS map");
#include <hip/hip_runtime.h>
#include <cstdio>
#include <cstdint>
namespace pg8 {
#define PG8_LAS __attribute__((address_space(3)))
typedef unsigned short bf16_t;
typedef short bf16x8 __attribute__((ext_vector_type(8)));
typedef float f32x4 __attribute__((ext_vector_type(4)));
typedef unsigned u32x4 __attribute__((ext_vector_type(4)));
constexpr int BM = 256, BK = 64, HALF = 128, HTB = HALF * BK * 2  , STAGE_BYTES = 8 * HTB, NXCD = 8, WGM = 8;

__host__ __device__ __forceinline__ int lds_byte(int r, int c) { const int st = (r >> 4) * 2 + (c >> 5), rr = r & 15, cc = c & 31, ob = rr * 64 + cc * 2; return st * 1024 + (ob ^ (((ob >> 9) & 1) << 5)); }
__host__ __device__ __forceinline__ void stage_rc(int b, int& R, int& C) { const int st = b / 1024, sb = b % 1024, swz = sb ^ (((sb >> 9) & 1) << 5); R = (st >> 1) * 16 + swz / 64; C = (st & 1) * 32 + (swz % 64) / 2; }
__host__ __device__ __forceinline__ int perm32(int rho) { const int n = rho >> 4, i = rho & 15; return 8 * (i >> 2) + 4 * n + (i & 3); }

struct Unit { int pm, pn, z, nt; size_t aoff, boff; };
struct Gemm { const unsigned char* base; int lda, ldb, K; };
__device__ __forceinline__ unsigned cvt_pk_bf16(float lo, float hi) { unsigned r; asm volatile("v_cvt_pk_bf16_f32 %0, %1, %2" : "=v"(r) : "v"(lo), "v"(hi)); return r; }
__device__ __forceinline__ u32x4 pack8(const f32x4 v0, const f32x4 v1) { u32x4 w; w.x = cvt_pk_bf16(v0[0], v0[1]); w.y = cvt_pk_bf16(v0[2], v0[3]); w.z = cvt_pk_bf16(v1[0], v1[1]); w.w = cvt_pk_bf16(v1[2], v1[3]); return w; }
__device__ __forceinline__ void st16_nt(void* p, const u32x4 v) { __builtin_nontemporal_store(v, (u32x4*)p); }
__device__ __forceinline__ void unpack8(const u32x4 w, f32x4& v0, f32x4& v1) {
    v0[0] = __uint_as_float(w.x << 16); v0[1] = __uint_as_float(w.x & 0xffff0000u); v0[2] = __uint_as_float(w.y << 16); v0[3] = __uint_as_float(w.y & 0xffff0000u);
    v1[0] = __uint_as_float(w.z << 16); v1[1] = __uint_as_float(w.z & 0xffff0000u); v1[2] = __uint_as_float(w.w << 16); v1[3] = __uint_as_float(w.w & 0xffff0000u); }

struct Map2D {
    int nM, nN, nwg;
    __device__ __forceinline__ void init(int nM_, int nN_) { nM = nM_; nN = nN_; nwg = nM_ * nN_; }
    __device__ __forceinline__ void map(int L, int& pm, int& pn) const {
        int wgid = L; { const int q = nwg / NXCD, r = nwg % NXCD, xcd = wgid % NXCD, off = wgid / NXCD; wgid = (xcd < r ? xcd * (q + 1) : r * (q + 1) + (xcd - r) * q) + off; }
        const int nig = WGM * nN, gid = wgid / nig, fm = gid * WGM, gsz = (nM - fm) < WGM ? (nM - fm) : WGM;
        pm = fm + ((wgid % nig) % gsz); pn = (wgid % nig) / gsz;
    }
};
struct SchedTiles {
    Map2D mp; int G, c, nt; size_t offA, offB, tA, tB;
    __device__ __forceinline__ bool next(int i, Unit& u) const { const int L = i * G + c; if (L >= mp.nwg) return false; mp.map(L, u.pm, u.pn); u.z = 0; u.nt = nt; u.aoff = offA + (size_t)u.pm * tA; u.boff = offB + (size_t)u.pn * tB; return true; }
};
struct SchedG1 {
    Map2D mp; int G, c; size_t offA, offB;
    __device__ __forceinline__ bool next(int i, Unit& u) const { const int L = i * G + c;
        int kq = 0;
        if (L < 1024) { mp.map(L, u.pm, u.pn); u.z = 0; u.nt = 32;
            { const int xi = (u.pn >> 4) * 4 + ((u.pn >> 2) & 3), r = ((u.pn >> 2) + u.pn) & 3; u.pn = r == 0 ? xi : (r == 1 ? 8 + xi : 16 + xi * 2 + (r & 1)); } }
        else { const int e = L - 1024; if (e >= 128) return false; const int tile = e >> 3; kq = e & 7; u.pm = 32 + (tile >> 3); u.pn = 4 + (tile & 7); u.z = 1 + kq; u.nt = 4; }
        u.aoff = offA + (size_t)u.pm * (256 * 2048 * 2) + (size_t)kq * 512; u.boff = offB + (size_t)u.pn * (256 * 2048 * 2) + (size_t)kq * 512; return true; }
};
struct SchedF1 {
    int G, c; size_t offCS, offFE, offFO;
    __device__ __forceinline__ bool next(int i, Unit& u) const { const int L = i * G + c; if (L >= 136) return false; u.pm = 0; u.nt = 4;
        if (L < 72) { const int g = L / 18, r = L % 18, b = r / 9; u.pn = r % 9; u.z = g | (b << 2); u.aoff = offCS; u.boff = offFE + ((size_t)(b * 2304 + u.pn * 256) * 1024 + (size_t)g * 256) * 2; }
        else { const int e = L - 72, g = e >> 4, r = e & 15, b = r >> 3; u.pn = r & 7; u.z = g | (b << 2) | 8; u.aoff = offCS + (size_t)(256 * 256 * 2); u.boff = offFO + ((size_t)(b * 2048 + u.pn * 256) * 1024 + (size_t)g * 256) * 2; }
        return true; }
};
struct SchedF2 {
    int G, c; size_t offD, offT;
    __device__ __forceinline__ bool next(int i, Unit& u) const { const int L = i * G + c; if (L >= 256) return false;
        const int idx = L >> 3, p = idx & 3, bg = idx >> 2, koff = (p >> 1) * FKC + (p & 1) * 1024; u.pm = L & 7; u.pn = 0; u.z = (bg << 2) | p; u.nt = p == 1 ? 18 : 16;
        u.aoff = offD + ((size_t)u.pm * 256 * FKP + (size_t)koff) * 2; u.boff = offT + ((size_t)bg * 256 * FKP + (size_t)koff) * 2; return true; }
};
struct SchedMerged {
    Map2D mp; int G, c; size_t offA0, offB0, offA1, offB1;
    __device__ __forceinline__ bool next(int i, Unit& u) const { const int L = (i >> 1) * G + c; if (L >= mp.nwg) return false; mp.map(L, u.pm, u.pn); u.z = i & 1; u.nt = 16;
        u.aoff = (u.z ? offA1 : offA0) + (size_t)u.pm * (256 * 1024 * 2); u.boff = (u.z ? offB1 : offB0) + (size_t)u.pn * (256 * 1024 * 2); return true; }
};

constexpr float QSCALE = 0.125f * 1.4426950408889634f;
struct EpiG1 {
    static constexpr bool PERM = true;
    unsigned char* ws; const float *ropec, *ropes;
    __device__ __forceinline__ bool operator()(f32x4 (&acc)[2][2][4][2], const Unit& u_, int wr, int wc, int fr, int fq) const {
        Unit u; u.pm = u_.pm; u.pn = u_.pn; u.z = u_.z; asm volatile("" : "+s"(u.pm), "+s"(u.pn), "+s"(u.z));
        const int type = u.pn >> 2;
        const bool ctx = u.pm >= 32;
        if (type <= 1 && !ctx) {
            bf16_t* O = (bf16_t*)(ws + WS_Q + (size_t)type * (WS_K - WS_Q)); const float sc = type == 0 ? QSCALE : 1.f;
            const int cl = (u.pn & 3) * 256 + wc * 32 + 8 * fq;
#pragma unroll
            for (int ai = 0; ai < 2; ++ai)
#pragma unroll
                for (int m = 0; m < 4; ++m) {
                    const int tok = u.pm * BM + ai * HALF + wr * 64 + m * 16 + fr, b = tok >> 12, l = tok & 4095;
                    const int pos = (wc & 1) ? (l & 63) : (l >> 6);
                    const float* cp = ropec + pos * 16 + 8 * (fq & 1); const float* sp = ropes + pos * 16 + 8 * (fq & 1);
                    const f32x4 c0 = *(const f32x4*)cp, c1 = *(const f32x4*)(cp + 4); f32x4 s0 = *(const f32x4*)sp, s1 = *(const f32x4*)(sp + 4);
                    if (fq < 2) { s0 = -s0; s1 = -s1; }
                    const size_t orow = type == 0 ? (size_t)tok : (size_t)(b * 4352 + l);
                    bf16_t* rowp = O + orow * 1024 + cl;
#pragma unroll
                    for (int bj = 0; bj < 2; ++bj) { const f32x4 v0 = acc[ai][bj][m][0], v1 = acc[ai][bj][m][1]; f32x4 p0, p1;
#pragma unroll
                        for (int j = 0; j < 4; ++j) {
                            const auto r0 = __builtin_amdgcn_permlane32_swap(__float_as_uint(v0[j]), __float_as_uint(v0[j]), false, false); p0[j] = __uint_as_float(fq < 2 ? r0[1] : r0[0]);
                            const auto r1 = __builtin_amdgcn_permlane32_swap(__float_as_uint(v1[j]), __float_as_uint(v1[j]), false, false); p1[j] = __uint_as_float(fq < 2 ? r1[1] : r1[0]); }
                        const f32x4 o0 = (v0 * c0 + p0 * s0) * sc, o1 = (v1 * c1 + p1 * s1) * sc;
                        *(u32x4*)(rowp + bj * HALF) = pack8(o0, o1); }
                }
        } else if (ctx) {
            bf16_t* P = (bf16_t*)(ws + WS_PART) + (size_t)(u.z - 1) * (512 * 2048) + (u.pn - 4) * 256 + wc * 32 + 8 * fq;
#pragma unroll
            for (int ai = 0; ai < 2; ++ai)
#pragma unroll
                for (int m = 0; m < 4; ++m) { bf16_t* rowp = P + (size_t)((u.pm - 32) * BM + ai * HALF + wr * 64 + m * 16 + fr) * 2048;
#pragma unroll
                    for (int bj = 0; bj < 2; ++bj) *(u32x4*)(rowp + bj * HALF) = pack8(acc[ai][bj][m][0], acc[ai][bj][m][1]); }
        } else if (type <= 3) {
            bf16_t* O = (bf16_t*)(ws + WS_K + (size_t)(type - 1) * (WS_V - WS_K));
            const int cl = (u.pn & 3) * 256 + wc * 32 + 8 * fq;
#pragma unroll
            for (int ai = 0; ai < 2; ++ai)
#pragma unroll
                for (int m = 0; m < 4; ++m) {
                    const int r = u.pm * BM + ai * HALF + wr * 64 + m * 16 + fr; size_t orow;
                    if (type == 3) orow = (size_t)r;
                    else orow = (size_t)((r >> 12) * 4352 + (r & 4095));
                    bf16_t* rowp = O + orow * 1024 + cl;
#pragma unroll
                    for (int bj = 0; bj < 2; ++bj) *(u32x4*)(rowp + bj * HALF) = pack8(acc[ai][bj][m][0], acc[ai][bj][m][1]);
                }
        } else {
            bf16_t* O = (bf16_t*)(ws + WS_SGA + (size_t)((type - 4) >> 1) * (WS_SGF - WS_SGA));
            const int cl = (u.pn & 7) * 256 + wc * 32 + 8 * fq;
#pragma unroll
            for (int ai = 0; ai < 2; ++ai)
#pragma unroll
                for (int m = 0; m < 4; ++m) {
                    const int r = u.pm * BM + ai * HALF + wr * 64 + m * 16 + fr; bf16_t* rowp = O + (size_t)r * 2048 + cl;
#pragma unroll
                    for (int bj = 0; bj < 2; ++bj) { f32x4 v0 = acc[ai][bj][m][0], v1 = acc[ai][bj][m][1];
#pragma unroll
                        for (int j = 0; j < 4; ++j) { v0[j] = __builtin_amdgcn_rcpf(1.f + __expf(-v0[j])); v1[j] = __builtin_amdgcn_rcpf(1.f + __expf(-v1[j])); }
                        st16_nt(rowp + bj * HALF, pack8(v0, v1)); }
                }
        }
        return false;
    }
};
struct EpiF1 {
    static constexpr bool PERM = true;
    bf16_t* TT;
    __device__ __forceinline__ bool operator()(f32x4 (&acc)[2][2][4][2], const Unit& u_, int wr, int wc, int fr, int fq) const {
        Unit u; u.pm = u_.pm; u.pn = u_.pn; u.z = u_.z; asm volatile("" : "+s"(u.pm), "+s"(u.pn), "+s"(u.z));
        const int g = u.z & 3, b = (u.z >> 2) & 1, cs = u.z >> 3;
#pragma unroll
        for (int ai = 0; ai < 2; ++ai)
#pragma unroll
            for (int m = 0; m < 4; ++m) { const int n = ai * HALF + wr * 64 + m * 16 + fr;
#pragma unroll
                for (int bj = 0; bj < 2; ++bj) { const int k0 = u.pn * BM + bj * HALF + wc * 32 + 8 * fq;
                    if (cs || k0 < FKC) *(u32x4*)(TT + ((size_t)((b * 4 + g) * 256 + n)) * FKP + cs * FKC + k0) = pack8(acc[ai][bj][m][0], acc[ai][bj][m][1]); } }
        return false;
    }
};
struct EpiF2 {
    static constexpr bool PERM = true;
    bf16_t* Y0;
    __device__ __forceinline__ bool operator()(f32x4 (&acc)[2][2][4][2], const Unit& u_, int wr, int wc, int fr, int fq) const {
        Unit u; u.pm = u_.pm; u.pn = u_.pn; u.z = u_.z; asm volatile("" : "+s"(u.pm), "+s"(u.pn), "+s"(u.z));
        const int p = u.z & 3, bg = u.z >> 2, b = bg >> 2, g = bg & 3; bf16_t* Y = Y0 + (size_t)p * (4096 * 1024);
#pragma unroll
        for (int ai = 0; ai < 2; ++ai)
#pragma unroll
            for (int m = 0; m < 4; ++m) { const int lp = u.pm * BM + ai * HALF + wr * 64 + m * 16 + fr; bf16_t* rowp = Y + ((size_t)(b * 2048 + lp)) * 1024 + g * 256 + wc * 32 + 8 * fq;
#pragma unroll
                for (int bj = 0; bj < 2; ++bj) *(u32x4*)(rowp + bj * HALF) = pack8(acc[ai][bj][m][0], acc[ai][bj][m][1]); }
        return false;
    }
};
struct EpiMerged {
    static constexpr bool PERM = true;
    const bf16_t *SGA, *SGF; bf16_t* Mb;
    __device__ __forceinline__ bool operator()(f32x4 (&acc)[2][2][4][2], const Unit& u_, int wr, int wc, int fr, int fq) const {
        Unit u; u.pm = u_.pm; u.pn = u_.pn; u.z = u_.z; asm volatile("" : "+s"(u.pm), "+s"(u.pn), "+s"(u.z));
        const int cl = u.pn * BM + wc * 32 + 8 * fq;
#pragma unroll
        for (int ai = 0; ai < 2; ++ai)
#pragma unroll
            for (int mp = 0; mp < 2; ++mp) {
                u32x4 gf[2][2], ga[2][2];
#pragma unroll
                for (int mm = 0; mm < 2; ++mm) { const size_t off = (size_t)(u.pm * BM + ai * HALF + wr * 64 + (2 * mp + mm) * 16 + fr) * 2048 + cl;
#pragma unroll
                    for (int bj = 0; bj < 2; ++bj) { gf[mm][bj] = __builtin_nontemporal_load((const u32x4*)(SGF + off + bj * HALF)); if (u.z == 0) ga[mm][bj] = __builtin_nontemporal_load((const u32x4*)(SGA + off + bj * HALF)); } }
                asm volatile("" ::: "memory");
#pragma unroll
                for (int mm = 0; mm < 2; ++mm) { const int m = 2 * mp + mm; const size_t off = (size_t)(u.pm * BM + ai * HALF + wr * 64 + m * 16 + fr) * 2048 + cl;
#pragma unroll
                    for (int bj = 0; bj < 2; ++bj) { f32x4 f0, f1; unpack8(gf[mm][bj], f0, f1);
                        if (u.z == 0) { f32x4 a0, a1; unpack8(ga[mm][bj], a0, a1);
#pragma unroll
                            for (int j = 0; j < 4; ++j) { acc[ai][bj][m][0][j] *= a0[j] * __builtin_amdgcn_rcpf(f0[j]); acc[ai][bj][m][1][j] *= a1[j] * __builtin_amdgcn_rcpf(f1[j]); }
                        } else *(u32x4*)(Mb + off + bj * HALF) = pack8(acc[ai][bj][m][0] * f0, acc[ai][bj][m][1] * f1); } }
                asm volatile("" ::: "memory"); }
        return u.z == 0;
    }
};
struct EpiRes {
    static constexpr bool PERM = false;
    const float* base; float* out; const float* gate;
    __device__ __forceinline__ bool operator()(f32x4 (&acc)[2][2][4][2], const Unit& u_, int wr, int wc, int fr, int fq) const {
        Unit u; u.pm = u_.pm; u.pn = u_.pn; u.z = u_.z; asm volatile("" : "+s"(u.pm), "+s"(u.pn), "+s"(u.z));
        const int b = u.pm >> 4, col0 = u.pn * BM + wc * 32 + 4 * fq; f32x4 gv[2][2];
#pragma unroll
        for (int bj = 0; bj < 2; ++bj)
#pragma unroll
            for (int n = 0; n < 2; ++n) gv[bj][n] = *(const f32x4*)(gate + (size_t)b * 12288 + col0 + bj * HALF + n * 16);
#pragma unroll
        for (int ai = 0; ai < 2; ++ai)
#pragma unroll
            for (int m = 0; m < 4; ++m) { const size_t off = (size_t)(u.pm * BM + ai * HALF + wr * 64 + m * 16 + fr) * 2048 + col0;
#pragma unroll
                for (int bj = 0; bj < 2; ++bj)
#pragma unroll
                    for (int n = 0; n < 2; ++n) *(f32x4*)(out + off + bj * HALF + n * 16) = *(const f32x4*)(base + off + bj * HALF + n * 16) + gv[bj][n] * acc[ai][bj][m][n]; }
        return false;
    }
};
struct EpiRelu2 {
    static constexpr bool PERM = true;
    bf16_t* Z;
    __device__ __forceinline__ bool operator()(f32x4 (&acc)[2][2][4][2], const Unit& u_, int wr, int wc, int fr, int fq) const {
        Unit u; u.pm = u_.pm; u.pn = u_.pn; u.z = u_.z; asm volatile("" : "+s"(u.pm), "+s"(u.pn), "+s"(u.z));
        const int cl = u.pn * BM + wc * 32 + 8 * fq;
#pragma unroll
        for (int ai = 0; ai < 2; ++ai)
#pragma unroll
            for (int m = 0; m < 4; ++m) { bf16_t* rowp = Z + (size_t)(u.pm * BM + ai * HALF + wr * 64 + m * 16 + fr) * 8192 + cl;
#pragma unroll
                for (int bj = 0; bj < 2; ++bj) { f32x4 v0 = acc[ai][bj][m][0], v1 = acc[ai][bj][m][1];
#pragma unroll
                    for (int j = 0; j < 4; ++j) { const float a = fmaxf(v0[j], 0.f), c = fmaxf(v1[j], 0.f); v0[j] = a * a; v1[j] = c * c; }
                    *(u32x4*)(rowp + bj * HALF) = pack8(v0, v1); } }
        return false;
    }
};
template <class Epi, class Sched, bool ALIGN_EPI = false, bool SP2 = false>
__device__ __forceinline__ void gemm_phase(PG8_LAS unsigned char* lds, const Gemm g, const Sched& S, const Epi& E) {
    const int tid = threadIdx.x, wid = __builtin_amdgcn_readfirstlane(tid >> 6), lane = tid & 63, wr = wid >> 2, wc = wid & 3, fr = lane & 15, fq = lane >> 4;
    unsigned voffA[2], voffB[2];
#pragma unroll
    for (int i = 0; i < 2; ++i) { int R, C; stage_rc(tid * 16 + i * 8192, R, C); const int Rb = Epi::PERM ? ((R & ~31) + perm32(R & 31)) : R;
        voffA[i] = (unsigned)(R * g.lda + C) * 2u; voffB[i] = (unsigned)(Rb * g.ldb + C) * 2u; }
    const size_t kstep = (size_t)(BK * 2);
    const size_t hstepA = (size_t)HALF * g.lda * 2, hstepB = (size_t)HALF * g.ldb * 2;
    const unsigned ldsw = (unsigned)wid * 1024u;
    const int aoff = lds_byte(wr * 64 + fr, fq * 8), boff = lds_byte(wc * 32 + fr, fq * 8);
#define PG8_SA(b, h) (((b) * 2 + (h)) * HTB)
#define PG8_SB(b, h) ((4 + (b) * 2 + (h)) * HTB)
#define PG8_STAGE(bufoff, gbase, voff) do { _Pragma("unroll") for (int _i = 0; _i < 2; ++_i) \
        __builtin_amdgcn_global_load_lds((const unsigned*)((const char*)(gbase) + (voff)[_i]), (PG8_LAS unsigned*)(lds + (bufoff) + ldsw + _i * 8192), 16, 0, 0); } while (0)
#define PG8_LDA(dst, b, h) do { _Pragma("unroll") for (int m = 0; m < 4; ++m) _Pragma("unroll") for (int k = 0; k < 2; ++k) dst[m][k] = *(const PG8_LAS bf16x8*)(lds + PG8_SA(b, h) + aoff + m * 2048 + k * 1024); } while (0)
#define PG8_LDB(dst, b, h) do { _Pragma("unroll") for (int n = 0; n < 2; ++n) _Pragma("unroll") for (int k = 0; k < 2; ++k) dst[n][k] = *(const PG8_LAS bf16x8*)(lds + PG8_SB(b, h) + boff + n * 2048 + k * 1024); } while (0)
#define PG8_MMA(ai, bj, At, Bt) do { __builtin_amdgcn_s_setprio(1); _Pragma("unroll") for (int m = 0; m < 4; ++m) _Pragma("unroll") for (int n = 0; n < 2; ++n) _Pragma("unroll") for (int k = 0; k < 2; ++k) \
        acc[ai][bj][m][n] = __builtin_amdgcn_mfma_f32_16x16x32_bf16(Bt[n][k], At[m][k], acc[ai][bj][m][n], 0, 0, 0); __builtin_amdgcn_s_setprio(0); } while (0)
#define PG8_WAIT_V(n) asm volatile("s_waitcnt vmcnt(" #n ")" ::: "memory")
#define PG8_WAIT_L(n) asm volatile("s_waitcnt lgkmcnt(" #n ")" ::: "memory")
#define PG8_BAR __builtin_amdgcn_s_barrier()
#define PG8_SCHED __builtin_amdgcn_sched_barrier(0)
    Unit cur, nxt; int ui = 0;
    if (!S.next(0, cur)) return;
    f32x4 acc[2][2][4][2];
#pragma unroll
    for (int a = 0; a < 2; ++a)
#pragma unroll
        for (int b = 0; b < 2; ++b)
#pragma unroll
            for (int m = 0; m < 4; ++m)
#pragma unroll
                for (int n = 0; n < 2; ++n) acc[a][b][m][n] = (f32x4){0.f, 0.f, 0.f, 0.f};
    bf16x8 At[4][2], B0[2][2], B1[2][2];
    const char* cA = (const char*)g.base + cur.aoff; const char* cB = (const char*)g.base + cur.boff;

    if constexpr (SP2) {
        PG8_STAGE(PG8_SB(0, 0), cB, voffB); PG8_STAGE(PG8_SB(0, 1), cB + hstepB, voffB); PG8_STAGE(PG8_SA(0, 0), cA, voffA); PG8_STAGE(PG8_SA(0, 1), cA + hstepA, voffA);
        if (wr == 1) PG8_BAR;
        PG8_WAIT_V(2); PG8_BAR;
        PG8_STAGE(PG8_SB(1, 0), cB + kstep, voffB); PG8_STAGE(PG8_SA(1, 0), cA + kstep, voffA); PG8_STAGE(PG8_SB(1, 1), cB + hstepB + kstep, voffB);
        PG8_WAIT_V(6); PG8_BAR;
    } else {
        PG8_STAGE(PG8_SB(0, 0), cB, voffB); PG8_STAGE(PG8_SA(0, 0), cA, voffA); PG8_STAGE(PG8_SB(0, 1), cB + hstepB, voffB); PG8_STAGE(PG8_SA(0, 1), cA + hstepA, voffA);
        if (wr == 1) PG8_BAR;
        PG8_WAIT_V(4); PG8_BAR;
        PG8_STAGE(PG8_SB(1, 0), cB + kstep, voffB); PG8_STAGE(PG8_SA(1, 0), cA + kstep, voffA); PG8_STAGE(PG8_SB(1, 1), cB + hstepB + kstep, voffB);
        PG8_WAIT_V(6); PG8_BAR;
    }
    for (;;) {
        const bool has_next = S.next(ui + 1, nxt);
        const char* nA = has_next ? (const char*)g.base + nxt.aoff : cA; const char* nB = has_next ? (const char*)g.base + nxt.boff : cB;
        int nt = cur.nt; asm volatile("" : "+s"(nt));
        for (int t = 0; t < nt; t += 2) {
            const bool last = (t == nt - 2);
            const char* a1 = cA + (size_t)(t + 1) * kstep;
            const char* a2 = last ? nA : cA + (size_t)(t + 2) * kstep; const char* b2 = last ? nB : cB + (size_t)(t + 2) * kstep;
            const char* a3 = a2 + kstep; const char* b3 = b2 + kstep;

            if constexpr (SP2) {
            PG8_LDB(B0, 0, 0); PG8_LDB(B1, 0, 1); PG8_SCHED; PG8_LDA(At, 0, 0); PG8_STAGE(PG8_SA(1, 1), a1 + hstepA, voffA);
            PG8_WAIT_V(8); PG8_WAIT_L(0); PG8_BAR; PG8_MMA(0, 0, At, B0); PG8_MMA(0, 1, At, B1); PG8_BAR; PG8_SCHED;
            PG8_LDA(At, 0, 1); PG8_STAGE(PG8_SB(0, 0), b2, voffB); PG8_STAGE(PG8_SB(0, 1), b2 + hstepB, voffB); PG8_STAGE(PG8_SA(0, 0), a2, voffA);
            PG8_WAIT_V(8); PG8_WAIT_L(0); PG8_BAR; PG8_MMA(1, 0, At, B0); PG8_MMA(1, 1, At, B1); PG8_BAR; PG8_SCHED;
            PG8_LDB(B0, 1, 0); PG8_LDB(B1, 1, 1); PG8_SCHED; PG8_LDA(At, 1, 0); PG8_STAGE(PG8_SA(0, 1), a2 + hstepA, voffA);
            PG8_WAIT_V(8); PG8_WAIT_L(0); PG8_BAR; PG8_MMA(0, 0, At, B0); PG8_MMA(0, 1, At, B1); PG8_BAR; PG8_SCHED;
            PG8_LDA(At, 1, 1); PG8_STAGE(PG8_SB(1, 0), b3, voffB); PG8_STAGE(PG8_SB(1, 1), b3 + hstepB, voffB); PG8_STAGE(PG8_SA(1, 0), a3, voffA);
            PG8_WAIT_V(8); PG8_WAIT_L(0); PG8_BAR; PG8_MMA(1, 0, At, B0); PG8_MMA(1, 1, At, B1); PG8_BAR; PG8_SCHED;
            } else {
            PG8_LDB(B0, 0, 0); PG8_SCHED; PG8_LDA(At, 0, 0); PG8_STAGE(PG8_SA(1, 1), a1 + hstepA, voffA);
            PG8_WAIT_L(8); PG8_BAR; PG8_WAIT_L(0); PG8_MMA(0, 0, At, B0); PG8_BAR; PG8_SCHED;
            PG8_LDB(B1, 0, 1); PG8_STAGE(PG8_SB(0, 0), b2, voffB);
            PG8_BAR; PG8_WAIT_L(0); PG8_MMA(0, 1, At, B1); PG8_BAR;
            PG8_LDA(At, 0, 1); PG8_STAGE(PG8_SA(0, 0), a2, voffA);
            PG8_BAR; PG8_WAIT_L(0); PG8_MMA(1, 0, At, B0); PG8_BAR; PG8_SCHED;
            PG8_STAGE(PG8_SB(0, 1), b2 + hstepB, voffB);
            PG8_WAIT_V(6); PG8_BAR; PG8_MMA(1, 1, At, B1); PG8_BAR;
            PG8_LDB(B0, 1, 0); PG8_SCHED; PG8_LDA(At, 1, 0); PG8_STAGE(PG8_SA(0, 1), a2 + hstepA, voffA);
            PG8_WAIT_L(8); PG8_BAR; PG8_WAIT_L(0); PG8_MMA(0, 0, At, B0); PG8_BAR; PG8_SCHED;
            PG8_LDB(B1, 1, 1); PG8_STAGE(PG8_SB(1, 0), b3, voffB);
            PG8_BAR; PG8_WAIT_L(0); PG8_MMA(0, 1, At, B1); PG8_BAR;
            PG8_LDA(At, 1, 1); PG8_STAGE(PG8_SA(1, 0), a3, voffA);
            PG8_BAR; PG8_WAIT_L(0); PG8_MMA(1, 0, At, B0); PG8_BAR; PG8_SCHED;
            PG8_STAGE(PG8_SB(1, 1), b3 + hstepB, voffB);
            PG8_WAIT_V(6); PG8_BAR; PG8_MMA(1, 1, At, B1); PG8_BAR;
            }
        }
        if constexpr (ALIGN_EPI) { if (wr == 0) PG8_BAR; }
        const bool keep = E(acc, cur, wr, wc, fr, fq);
        if (!has_next) break;
        if (!keep)
#pragma unroll
        for (int a = 0; a < 2; ++a)
#pragma unroll
            for (int b = 0; b < 2; ++b)
#pragma unroll
                for (int m = 0; m < 4; ++m)
#pragma unroll
                    for (int n = 0; n < 2; ++n) acc[a][b][m][n] = (f32x4){0.f, 0.f, 0.f, 0.f};
        cur = nxt; cA = nA; cB = nB; ++ui;
        if constexpr (ALIGN_EPI) { if (wr == 1) PG8_BAR; }
    }
    PG8_WAIT_V(0);
    if constexpr (!ALIGN_EPI) { if (wr == 0) PG8_BAR; }
    PG8_BAR;
#undef PG8_SA
#undef PG8_SB
#undef PG8_STAGE
#undef PG8_LDA
#undef PG8_LDB
#undef PG8_MMA
#undef PG8_WAIT_V
#undef PG8_WAIT_L
#undef PG8_BAR
#undef PG8_SCHED
}
}
#include <hip/hip_bf16.h>
#include <cmath>
namespace attn_body {
using bf16=__hip_bfloat16;
using bf16x8=__attribute__((ext_vector_type(8)))short;
using s16x4=__attribute__((ext_vector_type(4)))short;
using f32x16=__attribute__((ext_vector_type(16)))float;
using u32x4=__attribute__((ext_vector_type(4)))unsigned;
constexpr int BATCH=2,NHEAD=16,SEQ=4096,LK=4352,D=64,DM=NHEAD*D;
constexpr int NW=8,QBLK=32,QB=QBLK*NW,KVBLK=64,NQB=SEQ/QB;
constexpr int ATTN_PITCH=DM, ATTN_UNIT_ROWS=QB;
__device__ __forceinline__ int crow(int r,int hi){return (r&3)+8*(r>>2)+4*hi;}
#define SBAR() __builtin_amdgcn_sched_barrier(0)
constexpr int NSLOT=3, SLOTB=8192;
constexpr int LDS_K=0, LDS_V=NSLOT*SLOTB, LDS_WS=LDS_V+NSLOT*2*SLOTB, LDS_OST=LDS_WS+NW*64*4, LDS_BYTES=LDS_OST+NW*4096;
constexpr float C2=0.125f*1.4426950408889634f;
__device__ __forceinline__ void glds16(const void*gsrc,unsigned lds_dst){unsigned keep;
  asm volatile("s_mov_b32 %0, m0\n\ts_mov_b32 m0, %2\n\ts_nop 0\n\tglobal_load_lds_dwordx4 %1, off\n\ts_mov_b32 m0, %0":"=&s"(keep):"v"(gsrc),"s"(lds_dst):"memory");}
__device__ __forceinline__ float max3f(float a,float b,float c){float r;asm("v_max3_f32 %0, %1, %2, %3":"=v"(r):"v"(a),"v"(b),"v"(c));return r;}
__device__ __forceinline__ float max2f(float a,float b){float r;asm("v_max_f32_e32 %0, %1, %2":"=v"(r):"v"(a),"v"(b));return r;}
__device__ __forceinline__ float fadd_s(float a,float b){float r;asm("v_add_f32_e32 %0, %1, %2":"=v"(r):"v"(a),"v"(b));return r;}
__device__ __forceinline__ float fsub_s(float a,float b){float r;asm("v_sub_f32_e32 %0, %1, %2":"=v"(r):"v"(a),"v"(b));return r;}
typedef float f32x2_t __attribute__((ext_vector_type(2))); typedef __bf16 bf16x2_t __attribute__((ext_vector_type(2)));
__device__ __forceinline__ unsigned cvtpk_s(float lo,float hi){f32x2_t v={lo,hi};bf16x2_t b=__builtin_convertvector(v,bf16x2_t);return __builtin_bit_cast(unsigned,b);}
#define WAIT_BAR(N) asm volatile("s_waitcnt vmcnt(" #N ") lgkmcnt(0)\n\ts_barrier":::"memory")

__device__ __forceinline__ void qkt(f32x16&p0,f32x16&p1,const char*Kslot,const bf16x8*qr,const f32x16&negm,int r32,int hi){
  const char*kb=Kslot+hi*1024+r32*16;
  #pragma unroll
  for(int d0=0;d0<4;++d0){
    const bf16x8 b0=*reinterpret_cast<const bf16x8*>(kb+d0*2048);
    const bf16x8 b1=*reinterpret_cast<const bf16x8*>(kb+d0*2048+512);
    if(d0==0){p0=__builtin_amdgcn_mfma_f32_32x32x16_bf16(b0,qr[0],negm,0,0,0);p1=__builtin_amdgcn_mfma_f32_32x32x16_bf16(b1,qr[0],negm,0,0,0);}
    else{p0=__builtin_amdgcn_mfma_f32_32x32x16_bf16(b0,qr[d0],p0,0,0,0);p1=__builtin_amdgcn_mfma_f32_32x32x16_bf16(b1,qr[d0],p1,0,0,0);}}
}
typedef __attribute__((address_space(3))) const char* lds_cptr;
typedef short v4i16_t __attribute__((ext_vector_type(4)));
__device__ __forceinline__ void kload8(bf16x8*kf,lds_cptr kp){
  kf[0]=*(const __attribute__((address_space(3))) bf16x8*)(kp);      kf[1]=*(const __attribute__((address_space(3))) bf16x8*)(kp+512);
  kf[2]=*(const __attribute__((address_space(3))) bf16x8*)(kp+2048); kf[3]=*(const __attribute__((address_space(3))) bf16x8*)(kp+2560);
  kf[4]=*(const __attribute__((address_space(3))) bf16x8*)(kp+4096); kf[5]=*(const __attribute__((address_space(3))) bf16x8*)(kp+4608);
  kf[6]=*(const __attribute__((address_space(3))) bf16x8*)(kp+6144); kf[7]=*(const __attribute__((address_space(3))) bf16x8*)(kp+6656);
}
__device__ __forceinline__ void kload2(bf16x8*kf,lds_cptr kp,int j){ kf[2*j]=*(const __attribute__((address_space(3))) bf16x8*)(kp+j*2048); kf[2*j+1]=*(const __attribute__((address_space(3))) bf16x8*)(kp+j*2048+512); }
__device__ __forceinline__ s16x4 vtr(lds_cptr p){ return __builtin_bit_cast(s16x4,__builtin_amdgcn_ds_read_tr16_b64_v4i16((__attribute__((address_space(3))) v4i16_t*)p)); }
__device__ __forceinline__ float rowmax(const f32x16&p0,const f32x16&p1){
  float a=max3f(p0[0],p0[1],p1[0]),b=max3f(p0[2],p0[3],p1[1]);a=max3f(a,p1[2],p1[3]);
  #pragma unroll
  for(int r=4;r<16;r+=4){a=max3f(a,p0[r],p0[r+1]);b=max3f(b,p0[r+2],p0[r+3]);a=max3f(a,p1[r],p1[r+1]);b=max3f(b,p1[r+2],p1[r+3]);}
  const float m=max2f(a,b);
  auto rr=__builtin_amdgcn_permlane32_swap(__float_as_uint(m),__float_as_uint(m),false,false);
  return max2f(__uint_as_float(rr[0]),__uint_as_float(rr[1]));
}
__device__ __forceinline__ void pv(f32x16*o,int vb,bf16x8 pa0,bf16x8 pa1,bf16x8 pa2,bf16x8 pa3){
  #pragma unroll
  for(int d0=0;d0<4;++d0){s16x4 lo[4],hi[4];
    #pragma unroll
    for(int ks=0;ks<4;++ks){
      asm volatile("ds_read_b64_tr_b16 %0,%1 offset:%c2":"=&v"(lo[ks]):"v"(vb),"i"(d0*4096+ks*1024):"memory");
      asm volatile("ds_read_b64_tr_b16 %0,%1 offset:%c2":"=&v"(hi[ks]):"v"(vb),"i"(d0*4096+ks*1024+512):"memory");}
    asm volatile("s_waitcnt lgkmcnt(0)":::"memory");SBAR();
    #define PK(k) (bf16x8){lo[k][0],lo[k][1],lo[k][2],lo[k][3],hi[k][0],hi[k][1],hi[k][2],hi[k][3]}
    o[d0]=__builtin_amdgcn_mfma_f32_32x32x16_bf16(pa0,PK(0),o[d0],0,0,0);
    o[d0]=__builtin_amdgcn_mfma_f32_32x32x16_bf16(pa1,PK(1),o[d0],0,0,0);
    o[d0]=__builtin_amdgcn_mfma_f32_32x32x16_bf16(pa2,PK(2),o[d0],0,0,0);
    o[d0]=__builtin_amdgcn_mfma_f32_32x32x16_bf16(pa3,PK(3),o[d0],0,0,0);
    #undef PK
  }
}

#ifndef ATTN_STORE16
#define ATTN_STORE16(p,v) (*(u32x4*)(p)=(v))
#endif
template<int THRL> __device__ __forceinline__ void attn_unit(const bf16*Qu,const bf16*__restrict__ Kh,const bf16*__restrict__ Vh,bf16*Ou,char*shm){
  const int tid=threadIdx.x,lane=tid&63,r32=lane&31,hi=lane>>5; const int wid=__builtin_amdgcn_readfirstlane(tid>>6);
  const bf16*Qw=Qu+(long)wid*QBLK*DM;
  const unsigned lds0=(unsigned)(uintptr_t)shm;
  float*wsf=(float*)(shm+LDS_WS)+wid*64;
  const bf16*ksrc=Kh+(long)lane*DM+wid*8;
  const bf16*vsrc=Vh+(long)(16*(wid&3)+(lane>>2))*DM+(wid>>2)*32+(lane&3)*8;
  const unsigned kdst=lds0+LDS_K+wid*1024, vdst=lds0+LDS_V+wid*1024;
  #define DMA_K(t,slot) glds16(ksrc+(long)(t)*KVBLK*DM,(unsigned)__builtin_amdgcn_readfirstlane(kdst+(slot)))
  #define DMA_V(t,slot) do{ glds16(vsrc+(long)(t)*KVBLK*DM,(unsigned)__builtin_amdgcn_readfirstlane(vdst+2*(slot))); glds16(vsrc+(long)(t)*KVBLK*DM+64,(unsigned)__builtin_amdgcn_readfirstlane(vdst+2*(slot)+8192)); }while(0)
  const int vb0=(int)(lds0+LDS_V)+((lane>>4)&1)*32+(lane&3)*8+(4*hi+((lane&15)>>2))*64;
  const char*Kbase=shm+LDS_K; bf16x8 kf[8];
  const lds_cptr shm3=(lds_cptr)shm; const lds_cptr kp0=shm3+LDS_K+hi*1024+r32*16; const lds_cptr vp0=shm3+LDS_V+((lane>>4)&1)*32+(lane&3)*8+(4*hi+((lane&15)>>2))*64;
  constexpr int NT=LK/KVBLK;
  DMA_K(0,0);DMA_V(0,0);DMA_K(1,SLOTB);
  bf16x8 qr[4];
  #pragma unroll
  for(int d0=0;d0<4;++d0)qr[d0]=*reinterpret_cast<const bf16x8*>(&Qw[(long)r32*DM+d0*16+hi*8]);
  float mhat=0.f,l_reg=0.f;f32x16 o[4];o[0]=f32x16{};o[1]=f32x16{};o[2]=f32x16{};o[3]=f32x16{};float nm=0.f;
  #define CMASK(P0,P1,t) do{}while(0)
  bool resc=false;
  #define START(P0,P1) do{ const float rm=rowmax(P0,P1); resc=false; \
    { const float dl=rm; mhat=fadd_s(mhat,dl); \
      _Pragma("unroll") for(int r=0;r<16;++r){P0[r]=fsub_s(P0[r],dl);P1[r]=fsub_s(P1[r],dl);} \
      nm=-mhat; } \
    _Pragma("unroll") for(int r=0;r<16;++r)P0[r]=__builtin_amdgcn_exp2f(P0[r]); }while(0)
  #define RESC() do{ if(resc){ asm volatile("s_waitcnt lgkmcnt(0)":::"memory"); \
      _Pragma("unroll") for(int d_=0;d_<4;++d_) _Pragma("unroll") for(int r=0;r<16;++r)o[d_][r]*=wsf[crow(r,hi)]; } }while(0)
  f32x16 pA0,pA1,pB0,pB1;
  int sl_prev=0,sl_cur=0,sl_next=SLOTB;
  #define ROT() do{sl_prev=sl_cur;sl_cur=sl_next;sl_next=(sl_next==(NSLOT-1)*SLOTB)?0:sl_next+SLOTB;}while(0)
  DMA_K(2,2*SLOTB);
  WAIT_BAR(4);
  { f32x16 T0_; _Pragma("unroll") for(int r=0;r<16;++r)T0_[r]=nm; qkt(pA0,pA1,Kbase,qr,T0_,r32,hi); }asm volatile("s_nop 15\n\ts_nop 7":"+v"(pA0),"+v"(pA1));CMASK(pA0,pA1,0);
  START(pA0,pA1);
  _Pragma("unroll") for(int r=0;r<16;++r)pA1[r]=__builtin_amdgcn_exp2f(pA1[r]);
  WAIT_BAR(0);
  DMA_K(3,0);DMA_V(1,SLOTB);
  ROT();
  kload8(kf,kp0+sl_cur);
  WAIT_BAR(3);
  s16x4 vlo[8],vhi[8]; u32x4 pw0,pw1,pw2,pw3;
  #define PKW(P,B) cvtpk_s(P[B],P[B+1])
  #define PAF(k) __builtin_bit_cast(bf16x8,pw##k)
  #define VFR(i) (bf16x8){vlo[i][0],vlo[i][1],vlo[i][2],vlo[i][3],vhi[i][0],vhi[i][1],vhi[i][2],vhi[i][3]}
  #define PIN(x) asm volatile("":"+v"(x))
  #define MX3(a,b,c) __builtin_fmaxf(__builtin_fmaxf((a),(b)),(c))
  #define GAPA(MF,A0,A1,A2,A3,W0,W1,PW) do{ MF; sacc+=A0; sacc+=A1; sacc+=A2; sacc+=A3; PIN(sacc); W0; W1; PIN(PW); SBAR(); }while(0)
  #define EX(v) __builtin_amdgcn_exp2f(v)
  #define GAPB(MF,X,B) do{ MF; X[B]=EX(X[B]); X[B+1]=EX(X[B+1]); PIN(X); SBAR(); }while(0)
  #define VRD(i,d0,ks) do{ vlo[i]=vtr(vp_+((d0)*4096+(ks)*1024)); vhi[i]=vtr(vp_+((d0)*4096+(ks)*1024+512)); }while(0)
  #define KRD(G,j) do{ if(G){ kload2(kf,kp0+sl_next,j); SBAR(); } }while(0)
  #define STEP(C0,C1,P0,P1,t,GK,GV,GL) do{ SBAR(); \
    const lds_cptr vp_=vp0+2*sl_prev; f32x16 T_; _Pragma("unroll") for(int r=0;r<16;++r)T_[r]=nm; \
    VRD(0,0,0); SBAR(); float sacc=(P0[0]+P0[1]); \
    GAPA(C0=__builtin_amdgcn_mfma_f32_32x32x16_bf16(kf[0],qr[0],T_,0,0,0), P0[2],P0[3],P0[4],P0[5],     pw0[0]=PKW(P0,0), pw0[1]=PKW(P0,2), pw0); \
    GAPA(C1=__builtin_amdgcn_mfma_f32_32x32x16_bf16(kf[1],qr[0],T_,0,0,0), P0[6],P0[7],P0[8],P0[9],     pw0[2]=PKW(P0,4), pw0[3]=PKW(P0,6), pw0); \
    VRD(1,1,0); SBAR(); GAPA(C0=__builtin_amdgcn_mfma_f32_32x32x16_bf16(kf[2],qr[1],C0,0,0,0),   P0[10],P0[11],P0[12],P0[13], pw1[0]=PKW(P0,8), pw1[1]=PKW(P0,10), pw1); \
    GAPA(C1=__builtin_amdgcn_mfma_f32_32x32x16_bf16(kf[3],qr[1],C1,0,0,0),   P0[14],P0[15],P1[0],P1[1],   pw1[2]=PKW(P0,12),pw1[3]=PKW(P0,14), pw1); \
    VRD(2,0,1); SBAR(); GAPA(C0=__builtin_amdgcn_mfma_f32_32x32x16_bf16(kf[4],qr[2],C0,0,0,0),   P1[2],P1[3],P1[4],P1[5],     pw2[0]=PKW(P1,0), pw2[1]=PKW(P1,2), pw2); \
    GAPA(C1=__builtin_amdgcn_mfma_f32_32x32x16_bf16(kf[5],qr[2],C1,0,0,0),   P1[6],P1[7],P1[8],P1[9],     pw2[2]=PKW(P1,4), pw2[3]=PKW(P1,6), pw2); \
    VRD(3,1,1); SBAR(); GAPA(C0=__builtin_amdgcn_mfma_f32_32x32x16_bf16(kf[6],qr[3],C0,0,0,0),   P1[10],P1[11],P1[12],P1[13], pw3[0]=PKW(P1,8), pw3[1]=PKW(P1,10), pw3); \
    GAPA(C1=__builtin_amdgcn_mfma_f32_32x32x16_bf16(kf[7],qr[3],C1,0,0,0),   P1[14],P1[15],0.f,0.f,       pw3[2]=PKW(P1,12),pw3[3]=PKW(P1,14), pw3); \
    l_reg+=sacc; \
    if(GK){DMA_K((t)+3,sl_cur);} if(GV){DMA_V((t)+1,sl_next);} \
    CMASK(C0,C1,t); \
    { float a=MX3(C0[0],C0[1],C1[0]),b=MX3(C0[2],C0[3],C1[1]); a=MX3(a,C1[2],C1[3]); \
      _Pragma("unroll") for(int r=4;r<16;r+=4){a=MX3(a,C0[r],C0[r+1]);b=MX3(b,C0[r+2],C0[r+3]);a=MX3(a,C1[r],C1[r+1]);b=MX3(b,C1[r+2],C1[r+3]);} \
      float rm=__builtin_fmaxf(a,b); { auto rr=__builtin_amdgcn_permlane32_swap(__float_as_uint(rm),__float_as_uint(rm),false,false); rm=__builtin_fmaxf(__uint_as_float(rr[0]),__uint_as_float(rr[1])); } \
      resc=false; \
      if(__builtin_expect(__any(rm>(float)THRL),0)){ const float dl=__builtin_fmaxf(rm,0.f); mhat+=dl; \
        _Pragma("unroll") for(int r=0;r<16;++r){C0[r]-=dl;C1[r]-=dl;} \
        nm=-mhat; \
        const float f=__builtin_amdgcn_exp2f(-dl); l_reg*=f; if(hi==0)wsf[r32]=f; resc=true; } } \
    SBAR(); \
      \
    VRD(4,0,2); SBAR(); GAPB(o[0]=__builtin_amdgcn_mfma_f32_32x32x16_bf16(PAF(0),VFR(0),o[0],0,0,0), C0,0); \
    VRD(5,1,2); SBAR(); GAPB(o[1]=__builtin_amdgcn_mfma_f32_32x32x16_bf16(PAF(0),VFR(1),o[1],0,0,0), C0,2); \
    VRD(6,0,3); SBAR(); GAPB(o[0]=__builtin_amdgcn_mfma_f32_32x32x16_bf16(PAF(1),VFR(2),o[0],0,0,0), C0,4); \
    VRD(7,1,3); SBAR(); GAPB(o[1]=__builtin_amdgcn_mfma_f32_32x32x16_bf16(PAF(1),VFR(3),o[1],0,0,0), C0,6); \
      \
    KRD(GL,0); GAPB(o[0]=__builtin_amdgcn_mfma_f32_32x32x16_bf16(PAF(2),VFR(4),o[0],0,0,0), C0,8);  VRD(0,2,0); SBAR(); \
    KRD(GL,1); GAPB(o[1]=__builtin_amdgcn_mfma_f32_32x32x16_bf16(PAF(2),VFR(5),o[1],0,0,0), C0,10); VRD(1,3,0); SBAR(); \
    KRD(GL,2); GAPB(o[0]=__builtin_amdgcn_mfma_f32_32x32x16_bf16(PAF(3),VFR(6),o[0],0,0,0), C0,12); VRD(2,2,1); SBAR(); \
    KRD(GL,3); GAPB(o[1]=__builtin_amdgcn_mfma_f32_32x32x16_bf16(PAF(3),VFR(7),o[1],0,0,0), C0,14); VRD(3,3,1); SBAR(); \
      \
    GAPB(o[2]=__builtin_amdgcn_mfma_f32_32x32x16_bf16(PAF(0),VFR(0),o[2],0,0,0), C1,0);  VRD(4,2,2); SBAR(); \
    GAPB(o[3]=__builtin_amdgcn_mfma_f32_32x32x16_bf16(PAF(0),VFR(1),o[3],0,0,0), C1,2);  VRD(5,3,2); SBAR(); \
    GAPB(o[2]=__builtin_amdgcn_mfma_f32_32x32x16_bf16(PAF(1),VFR(2),o[2],0,0,0), C1,4);  VRD(6,2,3); SBAR(); \
    GAPB(o[3]=__builtin_amdgcn_mfma_f32_32x32x16_bf16(PAF(1),VFR(3),o[3],0,0,0), C1,6);  VRD(7,3,3); SBAR(); \
      \
    GAPB(o[2]=__builtin_amdgcn_mfma_f32_32x32x16_bf16(PAF(2),VFR(4),o[2],0,0,0), C1,8); \
    GAPB(o[3]=__builtin_amdgcn_mfma_f32_32x32x16_bf16(PAF(2),VFR(5),o[3],0,0,0), C1,10); \
    GAPB(o[2]=__builtin_amdgcn_mfma_f32_32x32x16_bf16(PAF(3),VFR(6),o[2],0,0,0), C1,12); \
    GAPB(o[3]=__builtin_amdgcn_mfma_f32_32x32x16_bf16(PAF(3),VFR(7),o[3],0,0,0), C1,14); \
    }while(0)
  int t=1;
  #undef CMASK
  #define CMASK(P0,P1,t) do{}while(0)
  for(;t+5<NT;t+=2){
    STEP(pB0,pB1,pA0,pA1,t,true,true,true);     WAIT_BAR(3); RESC(); ROT();
    STEP(pA0,pA1,pB0,pB1,t+1,true,true,true);   WAIT_BAR(3); RESC(); ROT();
  }
  #undef CMASK
  #define CMASK(P0,P1,t) do{}while(0)
  #define ENDW(tt) do{ if((tt)+3<NT){WAIT_BAR(3);} else if((tt)+2<NT){WAIT_BAR(2);} else {WAIT_BAR(0);} }while(0)
  for(;t+1<NT;t+=2){
    STEP(pB0,pB1,pA0,pA1,t,(t+3<NT),(t+1<NT),(t+1<NT));       ENDW(t);   RESC(); ROT();
    STEP(pA0,pA1,pB0,pB1,t+1,(t+4<NT),(t+2<NT),(t+2<NT));     ENDW(t+1); RESC(); ROT();
  }
  STEP(pB0,pB1,pA0,pA1,NT-1,false,false,false); RESC();
  { float sacc=pB0[0]+pB0[1]; _Pragma("unroll") for(int r=2;r<16;++r)sacc+=pB0[r]; _Pragma("unroll") for(int r=0;r<16;++r)sacc+=pB1[r]; l_reg+=sacc;
    pw0=(u32x4){PKW(pB0,0),PKW(pB0,2),PKW(pB0,4),PKW(pB0,6)};pw1=(u32x4){PKW(pB0,8),PKW(pB0,10),PKW(pB0,12),PKW(pB0,14)};pw2=(u32x4){PKW(pB1,0),PKW(pB1,2),PKW(pB1,4),PKW(pB1,6)};pw3=(u32x4){PKW(pB1,8),PKW(pB1,10),PKW(pB1,12),PKW(pB1,14)};
    SBAR(); pv(o,vb0+2*sl_cur,PAF(0),PAF(1),PAF(2),PAF(3)); }
  #undef PKW
  #undef PAF
  #undef VFR
  #undef PIN
  #undef MX3
  #undef GAPA
  #undef GAPB
  #undef EX
  #undef VRD
  #undef KRD
  #undef STEP
  #undef ENDW
  {auto rr=__builtin_amdgcn_permlane32_swap(__float_as_uint(l_reg),__float_as_uint(l_reg),false,false);l_reg=__uint_as_float(rr[0])+__uint_as_float(rr[1]);}
  if(hi==0)wsf[32+r32]=l_reg;asm volatile("s_waitcnt lgkmcnt(0)":::"memory");
  float rli[16];
  #pragma unroll
  for(int r=0;r<16;++r)rli[r]=__builtin_amdgcn_rcpf(wsf[32+crow(r,hi)]);
  bf16*Ow=Ou+(long)wid*QBLK*DM;
  { bf16*stg=(bf16*)(shm+LDS_OST)+wid*2048;
    #pragma unroll
    for(int hv=0;hv<2;++hv){
      #pragma unroll
      for(int r=0;r<16;++r){const int orow=crow(r,hi);
        #pragma unroll
        for(int d0=0;d0<2;++d0)stg[orow*64+d0*32+r32]=__float2bfloat16(o[2*hv+d0][r]*rli[r]);}
      asm volatile("s_waitcnt lgkmcnt(0)":::"memory");
      #pragma unroll
      for(int i=0;i<4;++i){const int row=i*8+(lane>>3),ch=lane&7; const u32x4 v=*(const u32x4*)(stg+row*64+ch*8); ATTN_STORE16(Ow+(long)row*DM+hv*64+ch*8,v);}
      asm volatile("s_waitcnt lgkmcnt(0)":::"memory");
    } }
  asm volatile("s_waitcnt lgkmcnt(0)\n\ts_barrier":::"memory");
  #undef DMA_K
  #undef DMA_V
  #undef CMASK
  #undef START
  #undef RESC
  #undef ROT
}
constexpr int ATTN_LDS_BYTES=LDS_BYTES;
#undef SBAR
#undef WAIT_BAR
}
#define GAS __attribute__((address_space(1)))
#define LAS __attribute__((address_space(3)))
typedef unsigned short bf16;
typedef unsigned v4u __attribute__((ext_vector_type(4)));
typedef float f32x4 __attribute__((ext_vector_type(4)));
typedef short bf16x8 __attribute__((ext_vector_type(8)));
typedef GAS unsigned gu32;
typedef GAS unsigned long long gu64;
#define RLX_AGENT __ATOMIC_RELAXED, __HIP_MEMORY_SCOPE_AGENT
#define LDS_WAIT() asm volatile("s_waitcnt lgkmcnt(0)" ::: "memory")
#define VM_WAIT() asm volatile("s_waitcnt vmcnt(0)" ::: "memory")
__device__ __forceinline__ unsigned long long rt() { return __builtin_amdgcn_s_memrealtime(); }
__device__ __forceinline__ unsigned f2bf(float f) { unsigned u = __builtin_bit_cast(unsigned, f); return (u + 0x7fffu + ((u >> 16) & 1u)) >> 16; }
__device__ __forceinline__ unsigned pk2(float lo, float hi) { return f2bf(lo) | (f2bf(hi) << 16); }

#define XB_TMO      128
#define XB_XCNT(j)  (256  + 64 * (j))
#define XB_XSUB(j)  (1280 + 64 * (j))
#define XB_XGEN(j)  (2304 + 64 * (j))
#define XB_TOP      3328
#define XB_TOPGEN   3392
#define XCD_BAR_WORDS 3456
#define XB_SPIN_CAP (1u << 18)

__device__ __forceinline__ unsigned xb_ld(unsigned* p)              { return __hip_atomic_load(p, __ATOMIC_RELAXED, __HIP_MEMORY_SCOPE_AGENT); }
__device__ __forceinline__ unsigned xb_add(unsigned* p, unsigned v) { return __hip_atomic_fetch_add(p, v, __ATOMIC_RELAXED, __HIP_MEMORY_SCOPE_AGENT); }
__device__ __forceinline__ unsigned xb_xcc_id() { return (unsigned)__builtin_amdgcn_s_getreg((3 << 11) | 20) & 0xFu; }
#define XB_SPIN(cond, bar) do { unsigned _sp = 0; while (cond) { __builtin_amdgcn_s_sleep(1); \
    if ((++_sp & 255u) == 0u) { if (xb_ld(&(bar)[XB_TMO])) break; if (_sp > XB_SPIN_CAP) { atomicAdd(&(bar)[XB_TMO], 1u); break; } } } } while (0)

struct XcdBarrier {
    unsigned* bar; unsigned x;
    volatile LAS unsigned* st;
};

__device__ __forceinline__ XcdBarrier xcd_barrier_post(unsigned* bar, volatile LAS unsigned* st) {
    XcdBarrier b; b.bar = bar; b.x = xb_xcc_id(); b.st = st;
    if (threadIdx.x == 0) (void)xb_add(&bar[XB_XCNT(b.x)], 1u);
    return b;
}
__device__ __forceinline__ void xcd_barrier_complete(unsigned* bar, unsigned x, unsigned& nloc, unsigned& nx) {
    const unsigned G = gridDim.x * gridDim.y * gridDim.z;
    unsigned sum, cnt, mine, sp = 0u;
    for (;;) {
        sum = 0u; cnt = 0u; mine = 0u;
#pragma unroll
        for (unsigned j = 0; j < 16; ++j) { const unsigned c = xb_ld(&bar[XB_XCNT(j)]); sum += c; cnt += (c > 0u) ? 1u : 0u; mine = (j == x) ? c : mine; }
        if (sum == G) break;
        __builtin_amdgcn_s_sleep(1);
        if ((++sp & 255u) == 0u) { if (xb_ld(&bar[XB_TMO])) break; if (sp > XB_SPIN_CAP) { atomicAdd(&bar[XB_TMO], 1u); break; } }
    }
    nloc = mine > 0u ? mine : 1u; nx = cnt > 0u ? cnt : 1u;
}

__device__ __forceinline__ void xcd_barrier(const XcdBarrier& b) {
    asm volatile("s_waitcnt vmcnt(0)" ::: "memory");
    __syncthreads();
    if (threadIdx.x == 0) {
        unsigned* bar = b.bar;
        __builtin_amdgcn_s_waitcnt(0);
        unsigned nloc = b.st[0], nx = b.st[1];
        if (nloc == 0u) { xcd_barrier_complete(bar, b.x, nloc, nx); b.st[0] = nloc; b.st[1] = nx; }
        const unsigned old = xb_add(&bar[XB_XSUB(b.x)], 1u);
        const unsigned gen = old / nloc;
        if (old + 1u == (gen + 1u) * nloc) {
            __builtin_amdgcn_fence(__ATOMIC_RELEASE, "agent");
            asm volatile("s_waitcnt vmcnt(0)" ::: "memory");
            const unsigned og = xb_add(&bar[XB_TOP], 1u);
            const unsigned tg = og / nx;
            if (og + 1u == (tg + 1u) * nx) xb_add(&bar[XB_TOPGEN], 1u);
            else XB_SPIN(xb_ld(&bar[XB_TOPGEN]) == tg, bar);
            __builtin_amdgcn_fence(__ATOMIC_ACQUIRE, "agent");
            xb_add(&bar[XB_XGEN(b.x)], 1u);
            asm volatile("s_waitcnt vmcnt(0)" ::: "memory");
        } else {
            XB_SPIN(xb_ld(&bar[XB_XGEN(b.x)]) == gen, bar);
            __builtin_amdgcn_fence(__ATOMIC_ACQUIRE, "agent");
            asm volatile("s_waitcnt vmcnt(0)" ::: "memory");
        }
    }
    __syncthreads();
}
#ifndef PROBE_SEL
#define PROBE_SEL -1
#endif
__device__ __forceinline__ float wave_sum(float v) {
#pragma unroll
    for (int o = 1; o < 64; o <<= 1) v += __shfl_xor(v, o);
    return v;
}
__device__ __forceinline__ void p0_transpose_item(const float* W, int K, int N, bf16* WT, LAS float* scr, int item, int lane) {
    const int nblk = N / 32, kb = item / nblk, nb = item % nblk, k0 = 64 * kb, n0 = 32 * nb;
    float rg[32];
    const float* wp = W + (size_t)(k0 + (lane >> 5)) * N + n0 + (lane & 31);
#pragma unroll
    for (int i = 0; i < 32; ++i) rg[i] = __builtin_nontemporal_load(wp + (size_t)(2 * i) * N);
#pragma unroll
    for (int i = 0; i < 32; ++i) scr[(2 * i + (lane >> 5)) * 33 + (lane & 31)] = rg[i];
    LDS_WAIT(); asm volatile("" ::: "memory");
    const int c = lane & 7;
#pragma unroll
    for (int j = 0; j < 4; ++j) { const int n = (lane >> 3) + 8 * j; const LAS float* s = scr + (8 * c) * 33 + n;
        v4u o; o.x = pk2(s[0 * 33], s[1 * 33]); o.y = pk2(s[2 * 33], s[3 * 33]); o.z = pk2(s[4 * 33], s[5 * 33]); o.w = pk2(s[6 * 33], s[7 * 33]);
        *(GAS v4u*)(WT + (size_t)(n0 + n) * K + k0 + 8 * c) = o; }
    LDS_WAIT(); asm volatile("" ::: "memory");
}
__device__ __forceinline__ void row_load(const float* xrow, int lane, f32x4 (&v)[8]) {
    const GAS f32x4* xr = (const GAS f32x4*)xrow + lane;
#pragma unroll
    for (int j = 0; j < 8; ++j) v[j] = xr[64 * j];
}
__device__ __forceinline__ void row_load_nt(const float* xrow, int lane, f32x4 (&v)[8]) {
    const f32x4* xr = (const f32x4*)xrow + lane;
#pragma unroll
    for (int j = 0; j < 8; ++j) v[j] = __builtin_nontemporal_load(xr + 64 * j);
}
__device__ __forceinline__ float row_rstd(const f32x4 (&v)[8]) {
    float s = 0.f;
#pragma unroll
    for (int j = 0; j < 8; ++j) s += (v[j].x * v[j].x + v[j].y * v[j].y) + (v[j].z * v[j].z + v[j].w * v[j].w);
    return 1.f / sqrtf(wave_sum(s) * (1.f / DM_) + EPS_);
}
__device__ __forceinline__ void norm_mod_store(const f32x4 (&v)[8], const float* g, const float* sh, const float* sc, bf16* orow, int lane) {
    const float rstd = row_rstd(v);
    GAS unsigned long long* o8 = (GAS unsigned long long*)orow + lane;
#pragma unroll
    for (int j = 0; j < 8; ++j) { const f32x4 gg = ((const GAS f32x4*)g)[64 * j + lane], hh = ((const GAS f32x4*)sh)[64 * j + lane], cc = ((const GAS f32x4*)sc)[64 * j + lane];
        const f32x4 y = v[j] * rstd * gg * (cc + 1.0f) + hh;
        o8[64 * j] = (unsigned long long)pk2(y.x, y.y) | ((unsigned long long)pk2(y.z, y.w) << 32); }
}
#define ROW_PIPE(m0, step, M, LOAD, BODY) ROW_PIPE_N(8, m0, step, M, LOAD, BODY)
#define ROW_PIPE_N(NB, m0, step, M, LOAD, BODY) do { int m_ = (m0); f32x4 va_[NB], vb_[NB]; if (m_ < (M)) { LOAD(va_, m_); } \
    while (m_ < (M)) { const int m1_ = m_ + (step); if (m1_ < (M)) { LOAD(vb_, m1_); } BODY(va_, m_); if (m1_ >= (M)) break; \
        const int m2_ = m1_ + (step); if (m2_ < (M)) { LOAD(va_, m2_); } BODY(vb_, m1_); m_ = m2_; } } while (0)

template <int MODE> struct EpiResNorm {
    static constexpr bool PERM = false;
    const float* base; float* out; const float* gate; float* rowsq; const float* gvec; const float* mod_sc; const float* mod_sh; bf16* xn; XcdBarrier bar; float probe_delta;
    __device__ __forceinline__ bool operator()(pg8::f32x4 (&acc)[2][2][4][2], const pg8::Unit& u_, int wr, int wc, int fr, int fq) const {
        pg8::Unit u; u.pm = u_.pm; u.pn = u_.pn; u.z = u_.z; asm volatile("" : "+s"(u.pm), "+s"(u.pn), "+s"(u.z));
        const int b = u.pm >> 4, col0 = u.pn * 256 + wc * 32 + 4 * fq;
        { f32x4 gv[2][2];
#pragma unroll
          for (int bj = 0; bj < 2; ++bj)
#pragma unroll
              for (int n = 0; n < 2; ++n) gv[bj][n] = *(const f32x4*)(gate + (size_t)b * NMOD + col0 + bj * 128 + n * 16);
#pragma unroll
          for (int ai = 0; ai < 2; ++ai)
#pragma unroll
              for (int mp = 0; mp < 2; ++mp) {
                  f32x4 bs[2][2][2];
#pragma unroll
                  for (int mm = 0; mm < 2; ++mm) { const size_t off = (size_t)(u.pm * 256 + ai * 128 + wr * 64 + (2 * mp + mm) * 16 + fr) * DM_ + col0;
#pragma unroll
                      for (int bj = 0; bj < 2; ++bj)
#pragma unroll
                          for (int n = 0; n < 2; ++n) bs[mm][bj][n] = __builtin_nontemporal_load((const f32x4*)(base + off + bj * 128 + n * 16)); }
                  asm volatile("" ::: "memory");
#pragma unroll
                  for (int mm = 0; mm < 2; ++mm) { const int m = 2 * mp + mm; const int row = u.pm * 256 + ai * 128 + wr * 64 + m * 16 + fr; float s = 0.f;
#pragma unroll
                      for (int bj = 0; bj < 2; ++bj)
#pragma unroll
                          for (int n = 0; n < 2; ++n) { const f32x4 y = bs[mm][bj][n] + gv[bj][n] * acc[ai][bj][m][n]; acc[ai][bj][m][n] = y; s += (y.x * y.x + y.y * y.y) + (y.z * y.z + y.w * y.w); }
                      s += __shfl_xor(s, 16); s += __shfl_xor(s, 32);
                      if (fq == 0) atomicAdd(rowsq + row, s); }
                  asm volatile("" ::: "memory"); } }
        xcd_barrier(bar);
        f32x4 Av[2][2], Bv[2][2];
#pragma unroll
        for (int bj = 0; bj < 2; ++bj)
#pragma unroll
            for (int n = 0; n < 2; ++n) { const int c = col0 + bj * 128 + n * 16; Av[bj][n] = *(const f32x4*)(gvec + c);
                if (MODE == 0) { Av[bj][n] = Av[bj][n] * (*(const f32x4*)(mod_sc + (size_t)b * NMOD + c) + 1.0f); Bv[bj][n] = *(const f32x4*)(mod_sh + (size_t)b * NMOD + c); } }
#pragma unroll
        for (int ai = 0; ai < 2; ++ai)
#pragma unroll
            for (int m = 0; m < 4; ++m) { const int row = u.pm * 256 + ai * 128 + wr * 64 + m * 16 + fr; const size_t off = (size_t)row * DM_ + col0;
                const float rstd = 1.f / sqrtf(__hip_atomic_load(rowsq + row, __ATOMIC_RELAXED, __HIP_MEMORY_SCOPE_AGENT) * (1.f / DM_) + EPS_);
#pragma unroll
                for (int bj = 0; bj < 2; ++bj)
#pragma unroll
                    for (int n = 0; n < 2; ++n) { const f32x4 y = acc[ai][bj][m][n];
                        if (MODE == 0) { __builtin_nontemporal_store(y, (f32x4*)(out + off + bj * 128 + n * 16)); const f32x4 h = y * rstd * Av[bj][n] + Bv[bj][n];
                            *(unsigned long long*)(xn + off + bj * 128 + n * 16) = (unsigned long long)pk2(h.x, h.y) | ((unsigned long long)pk2(h.z, h.w) << 32); }
                        else { f32x4 o = y * rstd * Av[bj][n]; if (PROBE_SEL >= 0 && blockIdx.x == 0) o = o + probe_delta; __builtin_nontemporal_store(o, (f32x4*)(out + off + bj * 128 + n * 16)); } } }
        return false;
    }
};

struct Args { const float* in[20]; float* out; unsigned char* ws; int ph_lo, ph_hi, li, coop; };
__global__ void __launch_bounds__(NWAVES * 64, 2) mk_fwd(Args args) {
    extern __shared__ __attribute__((aligned(16))) unsigned char lds[];
    LAS unsigned char* const ldsp = (LAS unsigned char*)lds;
    volatile LAS unsigned* MISC = (volatile LAS unsigned*)(ldsp + MISC_OFF);
    const int tid = threadIdx.x, lane = tid & 63, wave = __builtin_amdgcn_readfirstlane(tid >> 6);
    const int G = gridDim.x, bx = blockIdx.x; const int vcu = (G % 8 == 0) ? (bx % 8) * (G / 8) + bx / 8 : bx;
    unsigned char* ws = args.ws;
    gu32* ctl = (gu32*)(ws + WS_CTL);
    const float *x = args.in[0], *cvec = args.in[1], *ctxp = args.in[2], *c_ctx = args.in[3], *w_ada = args.in[4], *b_ada = args.in[5], *g_norm1 = args.in[6], *w_in = args.in[7],
                *lam_q1 = args.in[8], *lam_k1 = args.in[9], *lam_q2 = args.in[10], *lam_k2 = args.in[11], *g_subln = args.in[12], *w_attn_br = args.in[13], *w_four_br = args.in[14],
                *w_out = args.in[15], *g_norm2 = args.in[16], *w_mlp_in = args.in[17], *w_mlp_out = args.in[18], *g_final = args.in[19];
    float* out = args.out;
    float* MOD = (float*)(ws + WS_MOD);
    for (int u = tid; u < (LDS_BYTES - LDSCTL_OFF) / 4; u += NWAVES * 64) ((LAS unsigned*)(ldsp + LDSCTL_OFF))[u] = 0u;
    __syncthreads();
    XcdBarrier bar = xcd_barrier_post((unsigned*)(ctl + CW_BAR) + args.li * XCD_BAR_WORDS, MISC + 8);
    const int lo = args.ph_lo, hi = args.ph_hi;
    if (PROBE_SEL >= 0 && bx == 0 && tid == 0) MISC[16] = (unsigned)__builtin_amdgcn_s_memrealtime();
    if (PROBE_SEL >= 30 && tid == 0) ((unsigned*)(ws + 8192))[bx] = (unsigned)__builtin_amdgcn_s_memrealtime();
#ifndef PHMASK
#define PHMASK 0xfff
#endif
#define IN(k) ((((PHMASK) >> (k)) & 1) && lo <= (k) && (k) < hi)
#define STAMP(k) do { if (PROBE_SEL >= 0 && bx == 0 && tid == 0) MISC[16 + (k)] = (unsigned)__builtin_amdgcn_s_memrealtime(); } while (0)
#define SEAM(k) do { if (IN(k) && IN((k) + 1)) xcd_barrier(bar); STAMP((k) + 1); } while (0)
    const int gw = bx * NWAVES + wave, NGW = G * NWAVES, gt = bx * (NWAVES * 64) + tid, NGT = G * NWAVES * 64;

    if (IN(0)) {
        LAS float* scr = (LAS float*)(ldsp + RING_OFF + wave * 16384);
        constexpr int I_IN = (DM_ / 64) * (INCOLS / 32), I_AT = (1024 / 64) * (DM_ / 32), I_OUT = (DM_ / 64) * (DM_ / 32);
        constexpr int NITEMS = I_IN + 2 * I_AT + I_OUT;
        for (int it = gw; it < NITEMS; it += NGW) {
            int r = it;
            if (r < I_IN) { p0_transpose_item(w_in, DM_, INCOLS, (bf16*)(ws + WS_WIN), scr, r, lane); continue; } r -= I_IN;
            if (r < I_AT) { p0_transpose_item(w_attn_br, 1024, DM_, (bf16*)(ws + WS_WATT), scr, r, lane); continue; } r -= I_AT;
            if (r < I_AT) { p0_transpose_item(w_four_br, 1024, DM_, (bf16*)(ws + WS_WFOUR), scr, r, lane); continue; } r -= I_AT;
            p0_transpose_item(w_out, DM_, DM_, (bf16*)(ws + WS_WOUT), scr, r, lane);
        }
        { bf16* D = (bf16*)(ws + WS_DFTM);
          STAMP(14);
          LAS float* tab = (LAS float*)(ldsp + RING_OFF);
          __syncthreads();
          for (int j = tid; j < 4096; j += NWAVES * 64) tab[j] = cospif((float)j * (1.0f / 2048.0f));
          __syncthreads();
          for (int idx = gt; idx < 2048 * (FKP / 8); idx += NGT) {     const int lp = idx / (FKP / 8), c8 = (idx - lp * (FKP / 8)) * 8; float cv[8];
              const bool sn = c8 >= FKC; const int kb = sn ? c8 - FKC : c8;
#pragma unroll
              for (int e = 0; e < 8; ++e) { const int j = (lp * (kb + e)) & 4095; cv[e] = tab[sn ? ((j - 1024) & 4095) : j]; }
              v4u oc; oc.x = pk2(cv[0], cv[1]); oc.y = pk2(cv[2], cv[3]); oc.z = pk2(cv[4], cv[5]); oc.w = pk2(cv[6], cv[7]);
              *(GAS v4u*)(D + (size_t)lp * FKP + c8) = oc; } }
        STAMP(15);
        { bf16* CS = (bf16*)(ws + WS_CS);
          for (int idx = gt; idx < 512 * 256; idx += NGT) { const int mrow = idx >> 8, cc = idx & 255, n = mrow & 255; const float xx = (float)((n * cc) & 255) * (1.0f / 128.0f);
              CS[idx] = (bf16)f2bf((mrow >> 8) ? sinpif(xx) : cospif(xx)); } }
        { float* rc = (float*)(ws + WS_ROPEC); float* rs = (float*)(ws + WS_ROPES);
          for (int idx = gt; idx < 1024; idx += NGT) { const int pos = idx >> 4, j = idx & 15; const float inv = powf(10000.0f, -(float)(2 * j) / 32.0f); const float ang = (float)pos * inv; rc[idx] = cosf(ang); rs[idx] = sinf(ang); } }
        { LAS float* sil = (LAS float*)(ldsp + RING_OFF);
          LAS float* red = (LAS float*)(ldsp + RING_OFF + 24576);
          __syncthreads();
          for (int q = tid; q < 3 * 2048; q += NWAVES * 64) { const float v = q < 4096 ? cvec[q] : c_ctx[q - 4096]; sil[q] = v / (1.f + __expf(-v)); }
          __syncthreads();
          for (int blk = bx; blk < 192; blk += G) {
              const int ks = tid >> 4, cq = tid & 15, kbase = ks * 64;
              f32x4 a0 = {0.f, 0.f, 0.f, 0.f}, a1 = a0, a2 = a0;
              const float* wp = w_ada + (size_t)kbase * NMOD + blk * 64 + cq * 4;
#pragma unroll 16
              for (int kk = 0; kk < 64; ++kk) { const f32x4 w = __builtin_nontemporal_load((const f32x4*)(wp + (size_t)kk * NMOD));
                  a0 += w * sil[kbase + kk]; a1 += w * sil[2048 + kbase + kk]; a2 += w * sil[4096 + kbase + kk]; }
              LAS float* rp = red + (ks * 16 + cq) * 12;
#pragma unroll
              for (int e = 0; e < 4; ++e) { rp[e] = a0[e]; rp[4 + e] = a1[e]; rp[8 + e] = a2[e]; }
              __syncthreads();
              if (tid < 192) { float s = 0.f;
#pragma unroll
                  for (int q = 0; q < 32; ++q) s += red[q * 192 + tid];
                  const int cq2 = tid / 12, comp = tid % 12, col = blk * 64 + cq2 * 4 + (comp & 3);
                  MOD[(comp >> 2) * NMOD + col] = s + b_ada[col]; }
              __syncthreads();
          } }
        STAMP(12);
        if (PROBE_SEL >= 20 && PROBE_SEL < 30 && tid == 0) ((unsigned*)(ws + 8192))[bx] = (unsigned)__builtin_amdgcn_s_memrealtime();
        if (IN(1)) { if (args.coop) cg::this_grid().sync(); else xcd_barrier(bar); }
        STAMP(1);
    }
    if (IN(1)) {
        bf16* XN = (bf16*)(ws + WS_XN);
#define P1_LOAD(buf, m) row_load_nt((m) < MTOK ? x + (size_t)(m) * DM_ : ctxp + (size_t)((m) - MTOK) * DM_, lane, buf)
#define P1_BODY(buf, m) do { const float* md = MOD + (size_t)((m) < MTOK ? ((m) >> 12) : 2) * NMOD; norm_mod_store(buf, g_norm1, md, md + DM_, XN + (size_t)(m) * DM_, lane); } while (0)
        {
          const int b = gw & 1; const float* md = MOD + (size_t)b * NMOD; f32x4 Av[8], Bv[8];
#pragma unroll
          for (int j = 0; j < 8; ++j) { Av[j] = ((const GAS f32x4*)g_norm1)[64 * j + lane] * (((const GAS f32x4*)(md + DM_))[64 * j + lane] + 1.0f); Bv[j] = ((const GAS f32x4*)md)[64 * j + lane]; }
#define P1L_LOAD(buf, r) row_load_nt(x + ((size_t)(b * SEQ_ + (r))) * DM_, lane, buf)
#define P1L_BODY(buf, r) do { const float rstd = row_rstd(buf); GAS unsigned long long* o8 = (GAS unsigned long long*)(XN + ((size_t)(b * SEQ_ + (r))) * DM_) + lane; \
            _Pragma("unroll") for (int j = 0; j < 8; ++j) { const f32x4 y = buf[j] * rstd * Av[j] + Bv[j]; o8[64 * j] = (unsigned long long)pk2(y.x, y.y) | ((unsigned long long)pk2(y.z, y.w) << 32); } } while (0)
          ROW_PIPE(gw >> 1, NGW >> 1, SEQ_, P1L_LOAD, P1L_BODY); }
        ROW_PIPE(MTOK + gw, NGW, MTOK + MCTX, P1_LOAD, P1_BODY);
        SEAM(1);
    }
    if (IN(2)) {
        pg8::Gemm g{ws, DM_, DM_, DM_}; pg8::SchedG1 S; S.mp.init(32, 32); S.G = G; S.c = bx; S.offA = WS_XN; S.offB = WS_WIN;
        pg8::EpiG1 E{ws, (const float*)(ws + WS_ROPEC), (const float*)(ws + WS_ROPES)};
        pg8::gemm_phase<pg8::EpiG1, pg8::SchedG1, true, true>(ldsp + RING_OFF, g, S, E);
        SEAM(2);
    }
    if (IN(3)) {
        for (int t = gt; t < 512 * 256; t += NGT) { const int j = t >> 8, c8 = (t & 255) * 8; const bf16* P = (const bf16*)(ws + WS_PART) + (size_t)j * 2048 + c8;
            f32x4 s0, s1; pg8::unpack8(*(const GAS v4u*)P, s0, s1);
#pragma unroll
            for (int q = 1; q < 8; ++q) { f32x4 a0, a1; pg8::unpack8(*(const GAS v4u*)(P + (size_t)q * (512 * 2048)), a0, a1); s0 += a0; s1 += a1; }
            bf16* dst = (bf16*)(ws + WS_K + (size_t)(c8 >> 10) * (WS_V - WS_K)) + (size_t)((j >> 8) * 4352 + 4096 + (j & 255)) * 1024 + (c8 & 1023);
            *(GAS v4u*)dst = pg8::pack8(s0, s1); }
        { const bf16* Fb = (const bf16*)(ws + WS_F); bf16* FE = (bf16*)(ws + WS_FE); bf16* FO = (bf16*)(ws + WS_FO);
          for (int t = gt; t < 2 * 2304 * 128; t += NGT) { const int c8 = (t & 127) * 8, rk = t >> 7, b = rk / 2304, kk = rk - b * 2304;
              f32x4 a0 = {0.f, 0.f, 0.f, 0.f}, a1 = a0, c0 = a0, c1 = a0;
              if (kk <= 2048) pg8::unpack8(__builtin_nontemporal_load((const v4u*)(Fb + ((size_t)(b * 4096 + kk)) * 1024 + c8)), a0, a1);
              if (kk >= 1 && kk < 2048) pg8::unpack8(__builtin_nontemporal_load((const v4u*)(Fb + ((size_t)(b * 4096 + 4096 - kk)) * 1024 + c8)), c0, c1);
              *(GAS v4u*)(FE + ((size_t)(b * 2304 + kk)) * 1024 + c8) = pg8::pack8(a0 + c0, a1 + c1);
              if (kk < 2048) { if (kk == 0) { a0 = c0; a1 = c1; } *(GAS v4u*)(FO + ((size_t)(b * 2048 + kk)) * 1024 + c8) = pg8::pack8(a0 - c0, a1 - c1); } } }
        xcd_barrier(bar);
        pg8::Gemm g{ws, 256, 1024, 256}; pg8::SchedF1 S{G, bx, WS_CS, WS_FE, WS_FO};
        pg8::EpiF1 E{(bf16*)(ws + WS_TT)};
        pg8::gemm_phase<pg8::EpiF1, pg8::SchedF1, true, true>(ldsp + RING_OFF, g, S, E);
        SEAM(3);
    }
    if (IN(4)) {
        const attn_body::bf16 *Qb = (const attn_body::bf16*)(ws + WS_Q), *Kb = (const attn_body::bf16*)(ws + WS_K), *Vb = (const attn_body::bf16*)(ws + WS_V);
        for (int i = 0; ; ++i) { const int L = i * G + vcu; if (L >= 512) break;
            const int prob = (L & 255) >> 3, qb = ((L >> 8) << 3) | (L & 7), b = prob >> 4, h = (prob >> 1) & 7, c = prob & 1;
            attn_body::bf16* Ob = (attn_body::bf16*)(ws + WS_O0 + (size_t)c * (WS_O1 - WS_O0));
            attn_body::attn_unit<8>(Qb + ((size_t)(b * SEQ_ + qb * 256)) * 1024 + (h * 2 + c) * 64, Kb + (size_t)b * 4352 * 1024 + (h * 2 + c) * 64, Vb + (size_t)b * 4352 * 1024 + h * 128,
                                    Ob + ((size_t)(b * SEQ_ + qb * 256)) * 1024 + h * 128, (char*)lds + RING_OFF);
        }
        asm volatile("s_waitcnt vmcnt(0) lgkmcnt(0)" ::: "memory"); __syncthreads();
        STAMP(13);
        for (int w2 = gw; w2 < 2048; w2 += NGW) { const int b = w2 >> 10, ch = w2 & 1023; const bf16* row = (const bf16*)(ws + WS_TT) + ((size_t)((b * 4 + (ch >> 8)) * 256 + (ch & 255))) * FKP;
            float s = 0.f;
#pragma unroll
            for (int q = 0; q < 4; ++q) { f32x4 e0, e1; pg8::unpack8(*(const GAS v4u*)(row + lane * 32 + q * 8), e0, e1); s += (e0.x - e0.y) + (e0.z - e0.w) + (e1.x - e1.y) + (e1.z - e1.w); }
            s = wave_sum(s) + __uint_as_float((unsigned)row[2048] << 16);
            if (lane == 0) ((float*)(ws + WS_Y2048))[w2] = s; }
        pg8::Gemm g{ws, FKP, FKP, FKP}; pg8::SchedF2 S{G, bx, WS_DFTM, WS_TT};
        pg8::EpiF2 E{(bf16*)(ws + WS_YC)};
        pg8::gemm_phase<pg8::EpiF2, pg8::SchedF2, true, true>(ldsp + RING_OFF, g, S, E);
        SEAM(4);
    }
    if (IN(5)) {
        const float lam = __expf(wave_sum(lam_q1[lane] * lam_k1[lane])) - __expf(wave_sum(lam_q2[lane] * lam_k2[lane])) + LAM_INIT;
        const bf16 *O0 = (const bf16*)(ws + WS_O0), *O1 = (const bf16*)(ws + WS_O1); bf16 *AA = (bf16*)(ws + WS_AATT), *YB = (bf16*)(ws + WS_YB);
        const bf16* Yp = (const bf16*)(ws + WS_YC); const float* Y2048 = (const float*)(ws + WS_Y2048);
        f32x4 gs[4];
#pragma unroll
        for (int j = 0; j < 4; ++j) gs[j] = ((const GAS f32x4*)g_subln)[(lane & 7) * 4 + j] * (1.0f - LAM_INIT);
#define P5_LOAD(buf, m) do { const size_t off_ = (size_t)(m) * 1024 + lane * 16; \
            buf[0] = __builtin_nontemporal_load((const f32x4*)(O0 + off_)); buf[1] = __builtin_nontemporal_load((const f32x4*)(O0 + off_ + 8)); buf[2] = __builtin_nontemporal_load((const f32x4*)(O1 + off_)); buf[3] = __builtin_nontemporal_load((const f32x4*)(O1 + off_ + 8)); \
            const int lq_ = (m) & 4095, ls_ = lq_ < 2048 ? lq_ : (lq_ == 2048 ? 0 : 4096 - lq_); const size_t yo_ = ((size_t)(((m) >> 12) * 2048 + ls_)) * 1024 + lane * 16; \
            _Pragma("unroll") for (int p_ = 0; p_ < 4; ++p_) { buf[4 + 2 * p_] = __builtin_nontemporal_load((const f32x4*)(Yp + (size_t)p_ * (4096 * 1024) + yo_)); buf[5 + 2 * p_] = __builtin_nontemporal_load((const f32x4*)(Yp + (size_t)p_ * (4096 * 1024) + yo_ + 8)); } } while (0)
#define P5_BODY(buf, m) do { const size_t off = (size_t)(m) * 1024 + lane * 16; \
            f32x4 o[4], p[4]; pg8::unpack8(__builtin_bit_cast(v4u, buf[0]), o[0], o[1]); pg8::unpack8(__builtin_bit_cast(v4u, buf[1]), o[2], o[3]); \
            pg8::unpack8(__builtin_bit_cast(v4u, buf[2]), p[0], p[1]); pg8::unpack8(__builtin_bit_cast(v4u, buf[3]), p[2], p[3]); \
            float ss = 0.f; \
            _Pragma("unroll") for (int j = 0; j < 4; ++j) { o[j] = o[j] - p[j] * lam; ss += (o[j].x * o[j].x + o[j].y * o[j].y) + (o[j].z * o[j].z + o[j].w * o[j].w); } \
            ss += __shfl_xor(ss, 1); ss += __shfl_xor(ss, 2); ss += __shfl_xor(ss, 4); \
            const float r = 1.f / sqrtf(ss * (1.f / 128.f) + EPS_); \
            _Pragma("unroll") for (int j = 0; j < 4; ++j) o[j] = o[j] * r * gs[j]; \
            *(GAS v4u*)(AA + off) = pg8::pack8(o[0], o[1]); *(GAS v4u*)(AA + off + 8) = pg8::pack8(o[2], o[3]); \
            f32x4 y[4], q[4], t[4]; const int lq = (m) & 4095; const float sg = lq < 2048 ? -1.0f : 1.0f;     \
            pg8::unpack8(__builtin_bit_cast(v4u, buf[4]), y[0], y[1]); pg8::unpack8(__builtin_bit_cast(v4u, buf[5]), y[2], y[3]); pg8::unpack8(__builtin_bit_cast(v4u, buf[6]), t[0], t[1]); pg8::unpack8(__builtin_bit_cast(v4u, buf[7]), t[2], t[3]); \
            _Pragma("unroll") for (int j = 0; j < 4; ++j) y[j] = y[j] + t[j]; \
            pg8::unpack8(__builtin_bit_cast(v4u, buf[8]), q[0], q[1]); pg8::unpack8(__builtin_bit_cast(v4u, buf[9]), q[2], q[3]); pg8::unpack8(__builtin_bit_cast(v4u, buf[10]), t[0], t[1]); pg8::unpack8(__builtin_bit_cast(v4u, buf[11]), t[2], t[3]); \
            _Pragma("unroll") for (int j = 0; j < 4; ++j) y[j] = (y[j] + sg * (q[j] + t[j])) * (1.0f / 1024.0f); \
            if (lq == 2048) { _Pragma("unroll") for (int j = 0; j < 4; ++j) y[j] = *(const GAS f32x4*)(Y2048 + ((m) >> 12) * 1024 + lane * 16 + 4 * j) * (1.0f / 1024.0f); } \
            *(GAS v4u*)(YB + off) = pg8::pack8(y[0], y[1]); *(GAS v4u*)(YB + off + 8) = pg8::pack8(y[2], y[3]); } while (0)
        ROW_PIPE_N(12, gw, NGW, MTOK, P5_LOAD, P5_BODY);
        {
          LAS float* scr = (LAS float*)(ldsp + RING_OFF + wave * 16384);
          constexpr int I_1 = (DM_ / 64) * (DFF / 32), I_2 = (DFF / 64) * (DM_ / 32);
          for (int it = gw; it < I_1 + I_2; it += NGW) {
              if (it < I_1) p0_transpose_item(w_mlp_in, DM_, DFF, (bf16*)(ws + WS_WIN), scr, it, lane);
              else p0_transpose_item(w_mlp_out, DFF, DM_, (bf16*)(ws + WS_TT), scr, it - I_1, lane);
          } }
        SEAM(5);
    }
    if (IN(6)) {
        pg8::Gemm g{ws, 1024, 1024, 1024}; pg8::SchedMerged S; S.mp.init(32, 8); S.G = G; S.c = bx; S.offA0 = WS_AATT; S.offB0 = WS_WATT; S.offA1 = WS_YB; S.offB1 = WS_WFOUR;
        pg8::EpiMerged E{(const bf16*)(ws + WS_SGA), (const bf16*)(ws + WS_SGF), (bf16*)(ws + WS_MB)};
        pg8::gemm_phase<pg8::EpiMerged, pg8::SchedMerged, true, true>(ldsp + RING_OFF, g, S, E);
        SEAM(6);
    }
    if (IN(7)) {
        pg8::Gemm g{ws, DM_, DM_, DM_}; pg8::SchedTiles S; S.mp.init(32, 8); S.G = G; S.c = bx; S.nt = DM_ / 64; S.offA = WS_MB; S.offB = WS_WOUT; S.tA = (size_t)256 * DM_ * 2; S.tB = (size_t)256 * DM_ * 2;
        EpiResNorm<0> E{x, (float*)(ws + WS_XMID), MOD + 2 * DM_, (float*)(ws + WS_ROWSQ1), g_norm2, MOD + 4 * DM_, MOD + 3 * DM_, (bf16*)(ws + WS_XN), bar, 0.f};
        pg8::gemm_phase<EpiResNorm<0>, pg8::SchedTiles, true, true>(ldsp + RING_OFF, g, S, E);
        SEAM(7);
    }
    STAMP(9);
    if (IN(9)) {
        pg8::Gemm g{ws, DM_, DM_, DM_}; pg8::SchedTiles S; S.mp.init(32, 32); S.G = G; S.c = bx; S.nt = DM_ / 64; S.offA = WS_XN; S.offB = WS_WIN; S.tA = (size_t)256 * DM_ * 2; S.tB = (size_t)256 * DM_ * 2;
        pg8::EpiRelu2 E{(bf16*)(ws + WS_Z)};
        pg8::gemm_phase<pg8::EpiRelu2, pg8::SchedTiles, true, true>(ldsp + RING_OFF, g, S, E);
        SEAM(9);
    }
    if (IN(10)) {
        float probe_delta = 0.f;
        if (PROBE_SEL >= 0 && bx == 0) { float T_us;
            if (PROBE_SEL < 20) T_us = (float)(MISC[16 + (PROBE_SEL >= 0 && PROBE_SEL < 16 ? PROBE_SEL : 0)] - MISC[16]) * 0.01f;
            else { const unsigned* st = (const unsigned*)(ws + 8192); const unsigned t0 = MISC[16]; unsigned mx = 0, amx = 0, mn = 0xffffffffu, cnt = 0;
                for (int q = 0; q < G; ++q) { const unsigned d = st[q] - t0; if (d > mx) { mx = d; amx = q; } if (d < mn) mn = d; if (d > 6000u) ++cnt; }
                T_us = PROBE_SEL == 20 ? mx * 0.01f : PROBE_SEL == 21 ? (float)amx : PROBE_SEL == 22 ? mn * 0.01f : (float)cnt; }
            probe_delta = sqrtf(T_us * 2.56e-6f); }
        pg8::Gemm g{ws, DFF, DFF, DFF}; pg8::SchedTiles S; S.mp.init(32, 8); S.G = G; S.c = bx; S.nt = DFF / 64; S.offA = WS_Z; S.offB = WS_TT; S.tA = (size_t)256 * DFF * 2; S.tB = (size_t)256 * DFF * 2;
        EpiResNorm<1> E{(const float*)(ws + WS_XMID), out, MOD + 5 * DM_, (float*)(ws + WS_ROWSQ2), g_final, nullptr, nullptr, nullptr, bar, probe_delta};
        pg8::gemm_phase<EpiResNorm<1>, pg8::SchedTiles, true, true>(ldsp + RING_OFF, g, S, E);
    }
#undef IN
#undef SEAM
}

constexpr int NPHASE = 12;
extern "C" void kernel_launch(void* const* d_in, const int* in_sizes, int n_in, void* d_out, int out_size, void* d_ws, size_t ws_size, hipStream_t stream) {
    static int grid = 0;
    if (grid == 0) {
        if (n_in != 20 || in_sizes[0] != MTOK * DM_ || out_size != MTOK * DM_ || ws_size < WS_END) { fprintf(stderr, "kernel_launch: unexpected shapes / workspace (n_in %d, in0 %d, out %d, ws %zu, need %zu)\n", n_in, n_in > 0 ? in_sizes[0] : -1, out_size, ws_size, (size_t)WS_END); grid = -1; return; }
        int dev = 0, cus = 0, per_cu = 0;
        if (hipGetDevice(&dev) != hipSuccess || hipDeviceGetAttribute(&cus, hipDeviceAttributeMultiprocessorCount, dev) != hipSuccess) { fprintf(stderr, "kernel_launch: device query failed\n"); grid = -1; return; }
        if (hipFuncSetAttribute((const void*)mk_fwd, hipFuncAttributeMaxDynamicSharedMemorySize, LDS_BYTES) != hipSuccess) { fprintf(stderr, "kernel_launch: hipFuncSetAttribute failed\n"); grid = -1; return; }
        if (hipOccupancyMaxActiveBlocksPerMultiprocessor(&per_cu, (const void*)mk_fwd, NWAVES * 64, LDS_BYTES) != hipSuccess || per_cu < 1) { fprintf(stderr, "kernel_launch: occupancy query says %d blocks per CU\n", per_cu); per_cu = 1; }
        (void)hipGetLastError();
        grid = cus;
        if (cus != 256) { fprintf(stderr, "kernel_launch: built for a 256-CU device (one 256x256 tile per workgroup in the fused-norm GEMM phases); found %d CUs\n", cus); grid = -1; return; }
    }
    if (grid < 0) return;
    if (hipMemsetAsync((char*)d_ws + WS_CTL, 0, CTL_ZERO_BYTES, stream) != hipSuccess) { fprintf(stderr, "kernel_launch: memset failed\n"); return; }
    Args a{};
    for (int i = 0; i < 20; ++i) a.in[i] = (const float*)d_in[i];
    a.out = (float*)d_out; a.ws = (unsigned char*)d_ws; a.ph_lo = 0; a.ph_hi = NPHASE; a.li = 0; a.coop = 0;
    void* kargs[] = {&a};
    const hipError_t le = hipLaunchCooperativeKernel((const void*)mk_fwd, dim3(grid), dim3(NWAVES * 64), kargs, LDS_BYTES, stream);
    if (le != hipSuccess) fprintf(stderr, "kernel_launch: cooperative launch failed: %s (grid %d)\n", hipGetErrorString(le), grid);
}
```
